# Optimizing an MI355X kernel written in HIP

```python
import jax, jax.numpy as jnp
from jax import lax
import numpy as np

D_MODEL = 1024
BATCH = 8
SEQ = 2048
DEPTH = 2
DEC_BATCH = 128
DEC_SEQ = 8
PAST_LEN = 16384
PAGE_SIZE = 128

SGU_WIDTH = D_MODEL
SGU_GROUPS = 4
SGU_CHUNK = 128
MLSTM_WIDTH = D_MODEL
MLSTM_HEADS = 4
MLSTM_DK = MLSTM_WIDTH // MLSTM_HEADS
MLSTM_DV = MLSTM_WIDTH // MLSTM_HEADS
MLSTM_CHUNK = 128
POOL_WIDTH = D_MODEL
POOL_WINDOWS = (2, 4, 8, 16)
POOL_GROUPS = 4
POOL_BUF = 15
N_BRANCH = 3
EPS = 1e-6

IN_SIZES = (N_BRANCH * D_MODEL, SGU_WIDTH, SGU_WIDTH, SGU_WIDTH,
            MLSTM_WIDTH, MLSTM_WIDTH, MLSTM_WIDTH, MLSTM_WIDTH, MLSTM_WIDTH,
            MLSTM_HEADS, MLSTM_HEADS, POOL_WIDTH, POOL_WIDTH)
N_IN = sum(IN_SIZES)

kernel_name = "gated_sgu_mlstm_pool_decoder_step"


def rmsnorm(x, g):
    xf = x.astype(jnp.float32)
    y = xf * lax.rsqrt(jnp.mean(xf * xf, axis=-1, keepdims=True) + EPS)
    return (y * g.astype(jnp.float32)).astype(x.dtype)


def layernorm(x, g, b):
    xf = x.astype(jnp.float32)
    mu = jnp.mean(xf, axis=-1, keepdims=True)
    var = jnp.mean(jnp.square(xf - mu), axis=-1, keepdims=True)
    y = (xf - mu) * lax.rsqrt(var + EPS)
    return (y * g.astype(jnp.float32) + b.astype(jnp.float32)).astype(x.dtype)


def head_layernorm(h, g):
    B, T, W = h.shape
    hf = h.astype(jnp.float32).reshape(B, T, MLSTM_HEADS, W // MLSTM_HEADS)
    mu = jnp.mean(hf, axis=-1, keepdims=True)
    var = jnp.mean(jnp.square(hf - mu), axis=-1, keepdims=True)
    y = ((hf - mu) * lax.rsqrt(var + EPS)).reshape(B, T, W)
    return (y * g.astype(jnp.float32)).astype(h.dtype)


def chunk_spatial_gate(v, w_s, b_s):
    B, T, W = v.shape
    L = min(T, SGU_CHUNK)
    n_chunks = T // L
    vr = v.reshape(B, n_chunks, L, SGU_GROUPS, W // SGU_GROUPS)
    w = jnp.tril(w_s[:, :L, :L]).astype(v.dtype)
    s = jnp.einsum('gij,bnjgc->bnigc', w, vr) + b_s[:, :L].T.astype(v.dtype)[None, None, :, :, None]
    return s.reshape(B, T, W)


def mlstm(q, k, v, ig, fg, C0, n0, m0):
    B, T, _ = q.shape
    L = min(T, MLSTM_CHUNK)
    n_chunks = T // L

    def heads(a, d):
        return a.astype(jnp.float32).reshape(B, n_chunks, L, MLSTM_HEADS, d).transpose(1, 0, 3, 2, 4)

    def gates(a):
        return a.reshape(B, n_chunks, L, MLSTM_HEADS).transpose(1, 0, 3, 2)

    qh = heads(q, MLSTM_DK)
    kh = heads(k, MLSTM_DK) * (MLSTM_DK ** -0.5)
    vh = heads(v, MLSTM_DV)
    igh = gates(ig.astype(jnp.float32))
    lfh = gates(jax.nn.log_sigmoid(fg.astype(jnp.float32)))
    causal = jnp.tril(jnp.ones((L, L), dtype=bool))

    def step(carry, inp):
        C, n, m = carry
        qc, kc, vc, ic, lc = inp
        b = jnp.cumsum(lc, axis=-1)
        d_log = b[..., :, None] - b[..., None, :] + ic[..., None, :]
        d_log = jnp.where(causal, d_log, -jnp.inf)
        inter = b + m[..., None]
        m_t = jnp.maximum(inter, jnp.max(d_log, axis=-1))
        w_intra = jnp.exp(d_log - m_t[..., None])
        w_inter = jnp.exp(inter - m_t)
        s = jnp.einsum('bhtd,bhsd->bhts', qc, kc) * w_intra
        num = w_inter[..., None] * jnp.einsum('bhtd,bhde->bhte', qc, C) + jnp.einsum('bhts,bhse->bhte', s, vc)
        den = w_inter * jnp.einsum('bhtd,bhd->bht', qc, n) + jnp.sum(s, axis=-1)
        h = num / jnp.maximum(jnp.abs(den), jnp.exp(-m_t))[..., None]
        b_end = b[..., -1]
        log_end = b_end[..., None] - b + ic
        m_new = jnp.maximum(b_end + m, jnp.max(log_end, axis=-1))
        decay = jnp.exp(b_end + m - m_new)
        w_end = jnp.exp(log_end - m_new[..., None])
        kw = kc * w_end[..., None]
        C_new = decay[..., None, None] * C + jnp.einsum('bhsd,bhse->bhde', kw, vc)
        n_new = decay[..., None] * n + jnp.sum(kw, axis=2)
        return (C_new, n_new, m_new), h

    init = (C0.astype(jnp.float32), n0.astype(jnp.float32), m0.astype(jnp.float32))
    (C, n, m), hs = lax.scan(step, init, (qh, kh, vh, igh, lfh))
    h = hs.transpose(1, 0, 3, 2, 4).reshape(B, T, MLSTM_HEADS * MLSTM_DV)
    return h.astype(q.dtype), C, n, m


def multiscale_pool(p, buf, n_past):
    B, T, W = p.shape
    wg = W // POOL_GROUPS
    full = jnp.concatenate([buf.astype(p.dtype), p], axis=1)
    cs = jnp.cumsum(full.astype(jnp.float32), axis=1)
    cs = jnp.concatenate([jnp.zeros((B, 1, W), jnp.float32), cs], axis=1)
    end = cs[:, POOL_BUF + 1:]
    pos = jnp.arange(T) + n_past
    pf = p.astype(jnp.float32)
    outs = []
    for g, w in enumerate(POOL_WINDOWS):
        sl = slice(g * wg, (g + 1) * wg)
        start = cs[:, POOL_BUF + 1 - w:POOL_BUF + 1 - w + T, sl]
        cnt = jnp.minimum(pos + 1, w).astype(jnp.float32)
        outs.append((end[..., sl] - start) / cnt[None, :, None] - pf[..., sl])
    return jnp.concatenate(outs, axis=-1).astype(p.dtype), full[:, -POOL_BUF:]


def mixer_layer(x, c, st_C, st_n, st_m, pool_buf, n_past,
                w_mod, b_mod, norm_g, w_in, b_if, sgu_ln_g, sgu_ln_b, w_sgu, b_sgu,
                mlstm_norm_g, w_pool, pool_scale, w_br_a, w_br_b, w_br_c, w_out):
    B, T, _ = x.shape
    mod = jax.nn.silu(c) @ w_mod + b_mod
    shift, scale, gate = jnp.split(mod, 3, axis=-1)
    h = rmsnorm(x, norm_g) * (1 + scale[:, None]) + shift[:, None]
    proj = h @ w_in
    split_idx = np.cumsum(IN_SIZES)[:-1].tolist()
    (mg, u, va, za, q, k, vb, ob, zb, ig, fg, p, zc) = jnp.split(proj, split_idx, axis=-1)

    u = jax.nn.gelu(u)
    va = layernorm(jax.nn.gelu(va), sgu_ln_g, sgu_ln_b)
    ya = u * chunk_spatial_gate(va, w_sgu, b_sgu) * jax.nn.silu(za)

    hb, C_new, n_new, m_new = mlstm(q, k, vb, ig + b_if[:MLSTM_HEADS], fg + b_if[MLSTM_HEADS:], st_C, st_n, st_m)
    hb = jax.nn.sigmoid(ob) * hb
    yb = head_layernorm(hb, mlstm_norm_g) * jax.nn.silu(zb)

    pooled, new_buf = multiscale_pool(p, pool_buf, n_past)
    pg = pooled.reshape(B, T, POOL_GROUPS, POOL_WIDTH // POOL_GROUPS)
    pm = jnp.einsum('btgc,gcd->btgd', pg, w_pool).reshape(B, T, POOL_WIDTH)
    yc = pm * pool_scale * jax.nn.silu(zc)

    g_a, g_b, g_c = jnp.split(jax.nn.sigmoid(mg), 3, axis=-1)
    merged = g_a * (ya @ w_br_a) + g_b * (yb @ w_br_b) + g_c * (yc @ w_br_c)
    x = x + gate[:, None] * (merged @ w_out)
    return x, C_new, n_new, m_new, new_buf, va


def setup_inputs(seed: int = 0) -> dict:
    key = jax.random.key(seed)
    ks = jax.random.split(key, 26)
    f32 = jnp.float32

    def nrm(k, shape, s):
        return jax.random.normal(k, shape, f32) * s

    wg = POOL_WIDTH // POOL_GROUPS
    b_if = jnp.concatenate([nrm(ks[9], (DEPTH, MLSTM_HEADS), 0.1),
                            3.0 + nrm(ks[10], (DEPTH, MLSTM_HEADS), 0.1)], axis=-1)
    return {
        "x_prompt": nrm(ks[0], (BATCH, SEQ, D_MODEL), 1.0),
        "x_sample": nrm(ks[1], (DEC_BATCH, DEC_SEQ, D_MODEL), 1.0),
        "c_prompt": nrm(ks[2], (BATCH, D_MODEL), 1.0),
        "c_sample": nrm(ks[3], (DEC_BATCH, D_MODEL), 1.0),
        "state_mlstm_C": nrm(ks[4], (DEPTH, DEC_BATCH, MLSTM_HEADS, MLSTM_DK, MLSTM_DV), 0.1),
        "state_mlstm_n": nrm(ks[5], (DEPTH, DEC_BATCH, MLSTM_HEADS, MLSTM_DK), 0.1),
        "state_mlstm_m": nrm(ks[6], (DEPTH, DEC_BATCH, MLSTM_HEADS), 1.0),
        "state_pool": nrm(ks[7], (DEPTH, DEC_BATCH, POOL_BUF, POOL_WIDTH), 1.0),
        "w_mod": nrm(ks[8], (DEPTH, D_MODEL, 3 * D_MODEL), 0.5 * D_MODEL ** -0.5),
        "b_mod": nrm(ks[11], (DEPTH, 3 * D_MODEL), 0.02),
        "norm_g": 1.0 + nrm(ks[12], (DEPTH, D_MODEL), 0.02),
        "w_in": nrm(ks[13], (DEPTH, D_MODEL, N_IN), D_MODEL ** -0.5),
        "b_if": b_if,
        "sgu_ln_g": 1.0 + nrm(ks[14], (DEPTH, SGU_WIDTH), 0.02),
        "sgu_ln_b": nrm(ks[15], (DEPTH, SGU_WIDTH), 0.02),
        "w_sgu": nrm(ks[16], (DEPTH, SGU_GROUPS, SGU_CHUNK, SGU_CHUNK), 0.5 * SGU_CHUNK ** -0.5),
        "b_sgu": 1.0 + nrm(ks[17], (DEPTH, SGU_GROUPS, SGU_CHUNK), 0.02),
        "mlstm_norm_g": 1.0 + nrm(ks[18], (DEPTH, MLSTM_WIDTH), 0.02),
        "w_pool": nrm(ks[19], (DEPTH, POOL_GROUPS, wg, wg), wg ** -0.5),
        "pool_scale": 1.0 + nrm(ks[20], (DEPTH, POOL_WIDTH), 0.02),
        "w_br_a": nrm(ks[21], (DEPTH, SGU_WIDTH, D_MODEL), SGU_WIDTH ** -0.5),
        "w_br_b": nrm(ks[22], (DEPTH, MLSTM_WIDTH, D_MODEL), MLSTM_WIDTH ** -0.5),
        "w_br_c": nrm(ks[23], (DEPTH, POOL_WIDTH, D_MODEL), POOL_WIDTH ** -0.5),
        "w_out": nrm(ks[24], (DEPTH, D_MODEL, D_MODEL), D_MODEL ** -0.5),
        "final_norm_g": 1.0 + nrm(ks[25], (D_MODEL,), 0.02),
    }


def reference(x_prompt, x_sample, c_prompt, c_sample, state_mlstm_C, state_mlstm_n, state_mlstm_m, state_pool,
              w_mod, b_mod, norm_g, w_in, b_if, sgu_ln_g, sgu_ln_b, w_sgu, b_sgu, mlstm_norm_g,
              w_pool, pool_scale, w_br_a, w_br_b, w_br_c, w_out, final_norm_g):
    B = x_prompt.shape[0]
    xp, xs = x_prompt, x_sample
    Cp_l, np_l, mp_l, bp_l = [], [], [], []
    Cs_l, ns_l, ms_l, bs_l, vs_l = [], [], [], [], []
    for l in range(DEPTH):
        lw = (w_mod[l], b_mod[l], norm_g[l], w_in[l], b_if[l], sgu_ln_g[l], sgu_ln_b[l], w_sgu[l], b_sgu[l],
              mlstm_norm_g[l], w_pool[l], pool_scale[l], w_br_a[l], w_br_b[l], w_br_c[l], w_out[l])
        C0 = jnp.zeros((B, MLSTM_HEADS, MLSTM_DK, MLSTM_DV), jnp.float32)
        n0 = jnp.zeros((B, MLSTM_HEADS, MLSTM_DK), jnp.float32)
        m0 = jnp.zeros((B, MLSTM_HEADS), jnp.float32)
        buf0 = jnp.zeros((B, POOL_BUF, POOL_WIDTH), xp.dtype)
        xp, Cp, np_, mp, bp, _ = mixer_layer(xp, c_prompt, C0, n0, m0, buf0, 0, *lw)
        xs, Cs, ns, ms, bs, vs = mixer_layer(xs, c_sample, state_mlstm_C[l], state_mlstm_n[l], state_mlstm_m[l],
                                             state_pool[l], PAST_LEN, *lw)
        Cp_l.append(Cp); np_l.append(np_); mp_l.append(mp); bp_l.append(bp)
        Cs_l.append(Cs); ns_l.append(ns); ms_l.append(ms); bs_l.append(bs); vs_l.append(vs)
    y_prompt = rmsnorm(xp, final_norm_g)
    y_sample = rmsnorm(xs, final_norm_g)
    return (y_prompt, y_sample,
            jnp.stack(Cp_l), jnp.stack(np_l), jnp.stack(mp_l), jnp.stack(bp_l),
            jnp.stack(Cs_l), jnp.stack(ns_l), jnp.stack(ms_l), jnp.stack(bs_l), jnp.stack(vs_l))
```

```cpp
#include <hip/hip_runtime.h>
#include <hip/hip_cooperative_groups.h>
#include <cstdio>
#include <cstdint>
namespace cg = cooperative_groups;

#define DI __device__ __forceinline__
#define LAS __attribute__((address_space(3)))
#define GAS __attribute__((address_space(1)))
typedef unsigned short bf16_t;
typedef short bf16x8 __attribute__((ext_vector_type(8)));
typedef short s16x4 __attribute__((ext_vector_type(4)));
typedef float f32x4 __attribute__((ext_vector_type(4)));
typedef float f32x2 __attribute__((ext_vector_type(2)));
typedef float f32x16 __attribute__((ext_vector_type(16)));
typedef unsigned u32x4 __attribute__((ext_vector_type(4)));
typedef unsigned u32x2 __attribute__((ext_vector_type(2)));
typedef __bf16 bf16x2_t __attribute__((ext_vector_type(2)));
typedef LAS unsigned char* ldsp;

constexpr int D = 1024, PB = 8, PT = 2048, SB = 128, ST = 8;
constexpr int MP = PB * PT, MS = SB * ST, M = MP + MS, NB = PB + SB;
constexpr int NIN = 13320, NPROJ = 13312;
constexpr int C_MG = 0, C_U = 3072, C_VA = 4096, C_ZA = 5120, C_Q = 6144, C_K = 7168, C_V = 8192, C_OB = 9216, C_ZB = 10240, C_P = 11264, C_ZC = 12288;
constexpr int NCH = 16;
constexpr float EPS = 1e-6f;

constexpr size_t MiB = 1u << 20;
constexpr size_t WS_WIN = 1 * MiB;
constexpr size_t WS_WBR = WS_WIN + 52 * MiB;
constexpr size_t WS_WOUT = WS_WBR + 12 * MiB;
constexpr size_t WS_WPOOL = WS_WOUT + 4 * MiB;
constexpr size_t WS_WIF = WS_WPOOL + 1 * MiB;
constexpr size_t WS_MOD = WS_WIF + 1 * MiB;
constexpr size_t WS_H = WS_MOD + 4 * MiB;
constexpr size_t WS_GIF = WS_H + 34 * MiB;
constexpr size_t WS_LNS = WS_GIF + 1 * MiB;
constexpr size_t WS_POOLED = WS_LNS + 1 * MiB;
constexpr size_t WS_Y = WS_POOLED + 34 * MiB;
constexpr size_t WS_MERGED = WS_Y + 102 * MiB;
constexpr size_t WS_X1 = WS_MERGED + 34 * MiB;
constexpr size_t WS_CST = WS_X1 + 68 * MiB;
constexpr size_t WS_NST = WS_CST + 64 * MiB;
constexpr size_t WS_TOK = WS_NST + 1 * MiB;
constexpr size_t WS_PROJ = WS_TOK + 1 * MiB;
constexpr size_t WS_PART = WS_PROJ + 442 * MiB;
constexpr size_t WS_WOUT3 = WS_PART + 6 * MiB;
constexpr size_t WS_PO = WS_WOUT3 + 12 * MiB;
constexpr size_t WS_END = WS_PO + 12 * MiB;
static_assert((size_t)M * NPROJ * 2 <= 442 * MiB, "proj");
static_assert((size_t)M * D * 2 <= 34 * MiB, "act");

constexpr size_t O_Y = 0;
constexpr size_t O_CP = (size_t)M * D;
constexpr size_t O_NP = O_CP + 2ull * PB * 4 * 65536;
constexpr size_t O_MP = O_NP + 2ull * PB * 4 * 256;
constexpr size_t O_PP = O_MP + 2ull * PB * 4;
constexpr size_t O_CS = O_PP + 2ull * PB * 15 * 1024;
constexpr size_t O_NS = O_CS + 2ull * SB * 4 * 65536;
constexpr size_t O_MS = O_NS + 2ull * SB * 4 * 256;
constexpr size_t O_PS = O_MS + 2ull * SB * 4;
constexpr size_t O_VS = O_PS + 2ull * SB * 15 * 1024;
constexpr size_t O_END = O_VS + 2ull * SB * 8 * 1024;

constexpr int LDS_BYTES = 155648;

DI float bf_lo(unsigned w) { return __uint_as_float(w << 16); }
DI float bf_hi(unsigned w) { return __uint_as_float(w & 0xffff0000u); }
DI float bf2f(bf16_t h) { return __uint_as_float(((unsigned)h) << 16); }
DI unsigned pk2(float lo, float hi) { f32x2 v = {lo, hi}; bf16x2_t b = __builtin_convertvector(v, bf16x2_t); return __builtin_bit_cast(unsigned, b); }
DI bf16_t f2bf(float f) { return (bf16_t)(pk2(f, 0.f) & 0xffffu); }
DI float sigm(float t) { return __builtin_amdgcn_rcpf(1.f + __expf(-t)); }
template <int CTRL, int ROWMASK> DI float dpp_f(float v) { return __builtin_bit_cast(float, __builtin_amdgcn_update_dpp(0, __builtin_bit_cast(int, v), CTRL, ROWMASK, 0xF, false)); }
DI float wave_sum(float v) {
    v += dpp_f<0xB1, 0xF>(v);
    v += dpp_f<0x4E, 0xF>(v);
    v += dpp_f<0x141, 0xF>(v);
    v += dpp_f<0x140, 0xF>(v);
    v += dpp_f<0x142, 0xA>(v);
    v += dpp_f<0x143, 0xC>(v);
    return __builtin_bit_cast(float, __builtin_amdgcn_readlane(__builtin_bit_cast(int, v), 63));
}
DI float wave_max(float v) {
#pragma unroll
    for (int o = 1; o < 64; o <<= 1) v = fmaxf(v, __shfl_xor(v, o));
    return v;
}
DI void unpack8(u32x4 w, float* f) { f[0] = bf_lo(w.x); f[1] = bf_hi(w.x); f[2] = bf_lo(w.y); f[3] = bf_hi(w.y); f[4] = bf_lo(w.z); f[5] = bf_hi(w.z); f[6] = bf_lo(w.w); f[7] = bf_hi(w.w); }
DI int crow(int reg, int h) { return (reg & 3) + 8 * (reg >> 2) + 4 * h; }
DI int mod_row(int row) { return row < MP ? (row >> 11) : PB + ((row - MP) >> 3); }

#define MFMA32(a, b, c) __builtin_amdgcn_mfma_f32_32x32x16_bf16((a), (b), (c), 0, 0, 0)
typedef short v4i16_t __attribute__((ext_vector_type(4)));
DI s16x4 tr4(const LAS unsigned char* p) { return __builtin_bit_cast(s16x4, __builtin_amdgcn_ds_read_tr16_b64_v4i16((LAS v4i16_t*)p)); }
DI bf16x8 frag_row(const LAS unsigned char* base, int stride, int r0, int k0, int lane) {
    return *(const LAS bf16x8*)(base + (r0 + (lane & 31)) * stride + (k0 + 8 * (lane >> 5)) * 2);
}
DI bf16x8 frag_tr(const LAS unsigned char* base, int stride, int k0, int c0, int lane) {
    const int g = lane >> 4, i = lane & 15, q = i >> 2, p = i & 3, h = g >> 1;
    const LAS unsigned char* a = base + (k0 + 8 * h + q) * stride + (c0 + 16 * (g & 1) + 4 * p) * 2;
    const s16x4 lo = tr4(a), hi = tr4(a + 4 * stride);
    return __builtin_shufflevector(lo, hi, 0, 1, 2, 3, 4, 5, 6, 7);
}
DI bf16x8 frag_tr_perm(const LAS unsigned char* base, int stride, int k0, int c0, int lane) {
    const int g = lane >> 4, i = lane & 15, q = i >> 2, p = i & 3, h = g >> 1;
    const LAS unsigned char* a = base + (k0 + 4 * h + q) * stride + (c0 + 16 * (g & 1) + 4 * p) * 2;
    const s16x4 lo = tr4(a), hi = tr4(a + 8 * stride);
    return __builtin_shufflevector(lo, hi, 0, 1, 2, 3, 4, 5, 6, 7);
}

namespace pg8 {
constexpr int BM = 256, BK = 64, HALF = 128, HTB = HALF * BK * 2, STAGE_BYTES = 8 * HTB, NXCD = 8, WGM = 8;
__host__ __device__ __forceinline__ int lds_byte(int r, int c) { const int st = (r >> 4) * 2 + (c >> 5), rr = r & 15, cc = c & 31, ob = rr * 64 + cc * 2; return st * 1024 + (ob ^ (((ob >> 9) & 1) << 5)); }
__host__ __device__ __forceinline__ void stage_rc(int b, int& R, int& C) { const int st = b / 1024, sb = b % 1024, swz = sb ^ (((sb >> 9) & 1) << 5); R = (st >> 1) * 16 + swz / 64; C = (st & 1) * 32 + (swz % 64) / 2; }
__host__ __device__ __forceinline__ int perm32(int rho) { const int n = rho >> 4, i = rho & 15; return 8 * (i >> 2) + 4 * n + (i & 3); }

struct Unit { int pm, pn, z; };
struct Gemm { const bf16_t* A; const bf16_t* Bt; int lda, ldb, K; size_t zA, zB; };

struct Sched {
    int nM, nN, nz, zmode, nwg, G, c;
    __device__ void init(int Mr, int Nc, int nz_, int zmode_, int G_, int c_) { nM = Mr / BM; nN = Nc / BM; nz = nz_; zmode = zmode_; nwg = nM * nN; G = G_; c = c_; }
    __device__ bool next(int i, Unit& u) const {
        if (zmode == 3) {
            const int np = (c < nwg) ? (nwg - c + G - 1) / G : 0;
            if (i >= 3 * np) { const int sidx = c + G * (i - 3 * np); if (sidx >= 48) return false; const int tl = sidx / 3; u.pm = nM + (tl >> 2); u.pn = tl & 3; u.z = sidx - 3 * tl; return true; }
        }
        if (zmode == 4) {
            const int sidx = c + G * i; if (sidx >= 48) return false; const int tl = sidx / 3; u.pm = tl >> 2; u.pn = tl & 3; u.z = sidx - 3 * tl; return true;
        }
        int ti = i, z = 0;
        if (zmode == 1 || zmode == 3) { ti = i / nz; z = i - ti * nz; }
        const long L = (long)ti * G + c; if (L >= nwg) return false;
        int wgid = (int)L; { const int q = nwg / NXCD, r = nwg % NXCD, xcd = wgid % NXCD, off = wgid / NXCD; wgid = (xcd < r ? xcd * (q + 1) : r * (q + 1) + (xcd - r) * q) + off; }
        const int nig = WGM * nN, gid = wgid / nig, fm = gid * WGM, gsz = (nM - fm) < WGM ? (nM - fm) : WGM;
        u.pm = fm + ((wgid % nig) % gsz); u.pn = (wgid % nig) / gsz; u.z = z;
        if (zmode == 2) { u.z = u.pn; u.pn = 0; }
        return true;
    }
};

template <class Epi>
__device__ __forceinline__ void gemm_phase(ldsp lds, const Gemm g, const Sched& S, const Epi& E) {
    int tid_ = threadIdx.x; asm volatile("" : "+v"(tid_));
    const int tid = tid_, wid = __builtin_amdgcn_readfirstlane(tid >> 6), lane = tid & 63, wr = wid >> 2, wc = wid & 3, fr = lane & 15, fq = lane >> 4;
    const int K = g.K, nt = K / BK;
    unsigned voffA[2], voffB[2];
#pragma unroll
    for (int i = 0; i < 2; ++i) { int R, C; stage_rc(tid * 16 + i * 8192, R, C); const int Rb = Epi::PERM ? ((R & ~31) + perm32(R & 31)) : R;
        voffA[i] = (unsigned)(R * g.lda + C) * 2u; voffB[i] = (unsigned)(Rb * g.ldb + C) * 2u; }
    const size_t kstep = (size_t)(BK * 2);
    const size_t hsA = (size_t)HALF * g.lda * 2, hsB = (size_t)HALF * g.ldb * 2;
    const size_t tsA = 2 * hsA, tsB = 2 * hsB;
    const unsigned ldsw = (unsigned)wid * 1024u;
    const int aoff = lds_byte(wr * 64 + fr, fq * 8), boff = lds_byte(wc * 32 + fr, fq * 8);
#define PG8_SA(b, h) (((b) * 2 + (h)) * HTB)
#define PG8_SB(b, h) ((4 + (b) * 2 + (h)) * HTB)
#define PG8_STAGE(bufoff, gbase, voff) do { _Pragma("unroll") for (int _i = 0; _i < 2; ++_i) \
        __builtin_amdgcn_global_load_lds((const unsigned*)((const char*)(gbase) + (voff)[_i]), (LAS unsigned*)(lds + (bufoff) + ldsw + _i * 8192), 16, 0, 0); } while (0)
#define PG8_LDA(dst, b, h) do { _Pragma("unroll") for (int m = 0; m < 4; ++m) _Pragma("unroll") for (int k = 0; k < 2; ++k) dst[m][k] = *(const LAS bf16x8*)(lds + PG8_SA(b, h) + aoff + m * 2048 + k * 1024); } while (0)
#define PG8_LDB(dst, b, h) do { _Pragma("unroll") for (int n = 0; n < 2; ++n) _Pragma("unroll") for (int k = 0; k < 2; ++k) dst[n][k] = *(const LAS bf16x8*)(lds + PG8_SB(b, h) + boff + n * 2048 + k * 1024); } while (0)
#define PG8_MMA(ai, bj, At, Bt) do { __builtin_amdgcn_s_setprio(1); _Pragma("unroll") for (int m = 0; m < 4; ++m) _Pragma("unroll") for (int n = 0; n < 2; ++n) _Pragma("unroll") for (int k = 0; k < 2; ++k) \
        acc[ai][bj][m][n] = __builtin_amdgcn_mfma_f32_16x16x32_bf16(Bt[n][k], At[m][k], acc[ai][bj][m][n], 0, 0, 0); __builtin_amdgcn_s_setprio(0); } while (0)
#define PG8_WAIT_V(n) asm volatile("s_waitcnt vmcnt(" #n ")" ::: "memory")
#define PG8_WAIT_L(n) asm volatile("s_waitcnt lgkmcnt(" #n ")" ::: "memory")
#define PG8_BAR __builtin_amdgcn_s_barrier()
#define PG8_SCHED __builtin_amdgcn_sched_barrier(0)
    Unit cur, nxt; int ui = 0;
    if (!S.next(0, cur)) return;
    f32x4 acc[2][2][4][2];
#pragma unroll
    for (int a = 0; a < 2; ++a)
#pragma unroll
        for (int b = 0; b < 2; ++b)
#pragma unroll
            for (int m = 0; m < 4; ++m)
#pragma unroll
                for (int n = 0; n < 2; ++n) acc[a][b][m][n] = (f32x4){0.f, 0.f, 0.f, 0.f};
    bf16x8 At[4][2], B0[2][2], B1[2][2];
    const char* cA = (const char*)g.A + (size_t)cur.pm * tsA + (size_t)cur.z * g.zA; const char* cB = (const char*)g.Bt + (size_t)cur.pn * tsB + (size_t)cur.z * g.zB;
    PG8_STAGE(PG8_SB(0, 0), cB, voffB); PG8_STAGE(PG8_SB(0, 1), cB + hsB, voffB); PG8_STAGE(PG8_SA(0, 0), cA, voffA); PG8_STAGE(PG8_SA(0, 1), cA + hsA, voffA);
    if (wr == 1) PG8_BAR;
    PG8_WAIT_V(2); PG8_BAR;
    PG8_STAGE(PG8_SB(1, 0), cB + kstep, voffB); PG8_STAGE(PG8_SA(1, 0), cA + kstep, voffA); PG8_STAGE(PG8_SB(1, 1), cB + hsB + kstep, voffB);
    PG8_WAIT_V(6); PG8_BAR;
    for (;;) {
        const bool has_next = S.next(ui + 1, nxt);
        const char* nA = has_next ? (const char*)g.A + (size_t)nxt.pm * tsA + (size_t)nxt.z * g.zA : cA; const char* nB = has_next ? (const char*)g.Bt + (size_t)nxt.pn * tsB + (size_t)nxt.z * g.zB : cB;
        for (int t = 0; t < nt; t += 2) {
            const bool last = (t == nt - 2);
            const char* a1 = cA + (size_t)(t + 1) * kstep;
            const char* a2 = last ? nA : cA + (size_t)(t + 2) * kstep; const char* b2 = last ? nB : cB + (size_t)(t + 2) * kstep;
            const char* a3 = a2 + kstep; const char* b3 = b2 + kstep;
            PG8_LDB(B0, 0, 0); PG8_LDB(B1, 0, 1); PG8_SCHED; PG8_LDA(At, 0, 0); PG8_STAGE(PG8_SA(1, 1), a1 + hsA, voffA);
            PG8_WAIT_V(8); PG8_WAIT_L(0); PG8_BAR; PG8_MMA(0, 0, At, B0); PG8_MMA(0, 1, At, B1); PG8_BAR; PG8_SCHED;
            PG8_LDA(At, 0, 1); PG8_STAGE(PG8_SB(0, 0), b2, voffB); PG8_STAGE(PG8_SB(0, 1), b2 + hsB, voffB); PG8_STAGE(PG8_SA(0, 0), a2, voffA);
            PG8_WAIT_V(8); PG8_WAIT_L(0); PG8_BAR; PG8_MMA(1, 0, At, B0); PG8_MMA(1, 1, At, B1); PG8_BAR; PG8_SCHED;
            PG8_LDB(B0, 1, 0); PG8_LDB(B1, 1, 1); PG8_SCHED; PG8_LDA(At, 1, 0); PG8_STAGE(PG8_SA(0, 1), a2 + hsA, voffA);
            PG8_WAIT_V(8); PG8_WAIT_L(0); PG8_BAR; PG8_MMA(0, 0, At, B0); PG8_MMA(0, 1, At, B1); PG8_BAR; PG8_SCHED;
            PG8_LDA(At, 1, 1); PG8_STAGE(PG8_SB(1, 0), b3, voffB); PG8_STAGE(PG8_SB(1, 1), b3 + hsB, voffB); PG8_STAGE(PG8_SA(1, 0), a3, voffA);
            PG8_WAIT_V(8); PG8_WAIT_L(0); PG8_BAR; PG8_MMA(1, 0, At, B0); PG8_MMA(1, 1, At, B1); PG8_BAR; PG8_SCHED;
        }
        if (wr == 0) PG8_BAR;
        { int ln2 = __builtin_amdgcn_mbcnt_hi(~0u, __builtin_amdgcn_mbcnt_lo(~0u, 0u)); asm volatile("" : "+v"(ln2)); E(acc, cur, wr, wc, ln2 & 15, ln2 >> 4); }
        if (!has_next) break;
        if (!E.keep(cur)) {
#pragma unroll
        for (int a = 0; a < 2; ++a)
#pragma unroll
            for (int b = 0; b < 2; ++b)
#pragma unroll
                for (int m = 0; m < 4; ++m)
#pragma unroll
                    for (int n = 0; n < 2; ++n) acc[a][b][m][n] = (f32x4){0.f, 0.f, 0.f, 0.f};
        }
        cur = nxt; cA = nA; cB = nB; ++ui;
        if (wr == 1) PG8_BAR;
    }
    PG8_WAIT_V(0);
    PG8_BAR;
#undef PG8_SA
#undef PG8_SB
#undef PG8_STAGE
#undef PG8_LDA
#undef PG8_LDB
#undef PG8_MMA
#undef PG8_WAIT_V
#undef PG8_WAIT_L
#undef PG8_BAR
#undef PG8_SCHED
}

template <int MODE> DI float act(float x) {
    if (MODE == 0) return x;
    if (MODE == 4) return x * 0.0625f;
    const float t = (MODE == 3) ? 1.5957691216f * x * (1.f + 0.044715f * x * x) : x;
    const float sg = sigm(t);
    return MODE == 1 ? sg : x * sg;
}
struct EpiProj {
    static constexpr bool PERM = true;
    bf16_t* O;
    DI bool keep(const Unit&) const { return false; }
    template <int MODE> DI void run(f32x4 (&acc)[2][2][4][2], const Unit& u, int wr, int wc, int fr, int fq) const {
        const int row0 = u.pm * BM + wr * 64 + fr, col0 = u.pn * BM + wc * 32 + 8 * fq;
#pragma unroll
        for (int ai = 0; ai < 2; ++ai)
#pragma unroll
            for (int m = 0; m < 4; ++m) { bf16_t* rowp = O + (size_t)(row0 + ai * HALF + m * 16) * NPROJ + col0;
#pragma unroll
                for (int bj = 0; bj < 2; ++bj) { const f32x4 v0 = acc[ai][bj][m][0], v1 = acc[ai][bj][m][1]; u32x4 w;
                    w.x = pk2(act<MODE>(v0[0]), act<MODE>(v0[1])); w.y = pk2(act<MODE>(v0[2]), act<MODE>(v0[3]));
                    w.z = pk2(act<MODE>(v1[0]), act<MODE>(v1[1])); w.w = pk2(act<MODE>(v1[2]), act<MODE>(v1[3]));
                    *(GAS u32x4*)(rowp + bj * HALF) = w; } }
    }
    DI void operator()(f32x4 (&acc)[2][2][4][2], const Unit& u, int wr, int wc, int fr, int fq) const {
        const int seg = u.pn >> 2;
        if (seg <= 2 || seg == 9) run<1>(acc, u, wr, wc, fr, fq);
        else if (seg == 3 || seg == 4) run<3>(acc, u, wr, wc, fr, fq);
        else if (seg == 5 || seg == 10 || seg == 12) run<2>(acc, u, wr, wc, fr, fq);
        else if (seg == 7) run<4>(acc, u, wr, wc, fr, fq);
        else run<0>(acc, u, wr, wc, fr, fq);
    }
};
struct EpiPool {
    static constexpr bool PERM = true;
    bf16_t* O; const bf16_t* proj; const float* pscale;
    DI bool keep(const Unit&) const { return false; }
    DI void operator()(f32x4 (&acc)[2][2][4][2], const Unit& u, int wr, int wc, int fr, int fq) const {
        const int row0 = u.pm * BM + wr * 64 + fr, col0 = u.z * 256 + wc * 32 + 8 * fq;
        f32x4 sc[2][2];
#pragma unroll
        for (int bj = 0; bj < 2; ++bj) { sc[bj][0] = *(const GAS f32x4*)(pscale + col0 + bj * HALF); sc[bj][1] = *(const GAS f32x4*)(pscale + col0 + bj * HALF + 4); }
#pragma unroll
        for (int ai = 0; ai < 2; ++ai)
#pragma unroll
            for (int m = 0; m < 4; ++m) { const size_t row = (size_t)(row0 + ai * HALF + m * 16);
#pragma unroll
                for (int bj = 0; bj < 2; ++bj) { const int col = col0 + bj * HALF;
                    const u32x4 zw = *(const GAS u32x4*)(proj + row * NPROJ + C_ZC + col); float z[8]; unpack8(zw, z);
                    const f32x4 v0 = acc[ai][bj][m][0], v1 = acc[ai][bj][m][1], s0 = sc[bj][0], s1 = sc[bj][1]; u32x4 w;
                    w.x = pk2(v0[0] * s0[0] * z[0], v0[1] * s0[1] * z[1]); w.y = pk2(v0[2] * s0[2] * z[2], v0[3] * s0[3] * z[3]);
                    w.z = pk2(v1[0] * s1[0] * z[4], v1[1] * s1[1] * z[5]); w.w = pk2(v1[2] * s1[2] * z[6], v1[3] * s1[3] * z[7]);
                    *(GAS u32x4*)(O + row * D + col) = w; }
                asm volatile("" ::: "memory"); }
    }
};
struct EpiMerge {
    static constexpr bool PERM = true;
    bf16_t* O; bf16_t* part; const bf16_t* proj;
    DI bool keep(const Unit& u) const { return u.pm < MP / BM && u.z < 2; }
    DI void operator()(f32x4 (&acc)[2][2][4][2], const Unit& u, int wr, int wc, int fr, int fq) const {
        const int row0 = u.pm * BM + wr * 64 + fr, col0 = u.pn * BM + wc * 32 + 8 * fq;
        const bool samp = u.pm >= MP / BM;
#pragma unroll
        for (int ai = 0; ai < 2; ++ai)
#pragma unroll
            for (int m = 0; m < 4; ++m) { const size_t row = (size_t)(row0 + ai * HALF + m * 16);
#pragma unroll
                for (int bj = 0; bj < 2; ++bj) { const int col = col0 + bj * HALF;
                    const u32x4 gw = *(const GAS u32x4*)(proj + row * NPROJ + C_MG + u.z * 1024 + col); float gt[8]; unpack8(gw, gt);
                    f32x4& v0 = acc[ai][bj][m][0]; f32x4& v1 = acc[ai][bj][m][1];
                    if (samp || u.z == 2) {
                        u32x4 w;
                        w.x = pk2(gt[0] * v0[0], gt[1] * v0[1]); w.y = pk2(gt[2] * v0[2], gt[3] * v0[3]);
                        w.z = pk2(gt[4] * v1[0], gt[5] * v1[1]); w.w = pk2(gt[6] * v1[2], gt[7] * v1[3]);
                        if (samp) *(GAS u32x4*)(part + (row - MP) * 3072 + u.z * 1024 + col) = w; else *(GAS u32x4*)(O + row * D + col) = w;
                    } else {
                        const u32x4 nw = *(const GAS u32x4*)(proj + row * NPROJ + C_MG + (u.z + 1) * 1024 + col); float gn[8]; unpack8(nw, gn);
#pragma unroll
                        for (int e = 0; e < 8; ++e) gt[e] *= __builtin_amdgcn_rcpf(fmaxf(gn[e], 1e-30f));
                        v0[0] *= gt[0]; v0[1] *= gt[1]; v0[2] *= gt[2]; v0[3] *= gt[3]; v1[0] *= gt[4]; v1[1] *= gt[5]; v1[2] *= gt[6]; v1[3] *= gt[7];
                    } }
                if (m & 1) asm volatile("" ::: "memory"); }
    }
};
struct EpiOut {
    static constexpr bool PERM = false;
    const float* xp; const float* xs; float* out; const float* modg;
    DI bool keep(const Unit&) const { return false; }
    DI void operator()(f32x4 (&acc)[2][2][4][2], const Unit& u, int wr, int wc, int fr, int fq) const {
        const int row0 = u.pm * BM + wr * 64 + fr, col0 = u.pn * BM + wc * 32 + 4 * fq;
#pragma unroll
        for (int ai = 0; ai < 2; ++ai)
#pragma unroll
            for (int m = 0; m < 4; ++m) { const int row = row0 + ai * HALF + m * 16;
                const float* xr = row < MP ? xp + (size_t)row * D : xs + (size_t)(row - MP) * D;
                const float* gr = modg + (size_t)mod_row(row) * 3072;
#pragma unroll
                for (int bj = 0; bj < 2; ++bj)
#pragma unroll
                    for (int n = 0; n < 2; ++n) { const int col = col0 + bj * HALF + n * 16;
                        const f32x4 xv = *(const GAS f32x4*)(xr + col), gv = *(const GAS f32x4*)(gr + col);
                        *(GAS f32x4*)(out + (size_t)row * D + col) = xv + gv * acc[ai][bj][m][n]; } }
    }
};
struct EpiOutPart {
    static constexpr bool PERM = false;
    float* po; const float* modg;
    DI bool keep(const Unit&) const { return false; }
    DI void operator()(f32x4 (&acc)[2][2][4][2], const Unit& u, int wr, int wc, int fr, int fq) const {
        const int row0 = u.pm * BM + wr * 64 + fr, col0 = u.pn * BM + wc * 32 + 4 * fq;
        float* ob = po + (size_t)u.z * MS * D;
#pragma unroll
        for (int ai = 0; ai < 2; ++ai)
#pragma unroll
            for (int m = 0; m < 4; ++m) { const int row = row0 + ai * HALF + m * 16;
                const float* gr = modg + (size_t)(PB + (row >> 3)) * 3072;
#pragma unroll
                for (int bj = 0; bj < 2; ++bj)
#pragma unroll
                    for (int n = 0; n < 2; ++n) { const int col = col0 + bj * HALF + n * 16;
                        const f32x4 gv = *(const GAS f32x4*)(gr + col);
                        *(GAS f32x4*)(ob + (size_t)row * D + col) = gv * acc[ai][bj][m][n]; } }
    }
};
}

struct Params { const float* in[25]; float* out; unsigned char* ws; int ph_lo, ph_hi; };
enum { I_XP = 0, I_XS, I_CP, I_CS, I_SC, I_SN, I_SM, I_SP, I_WMOD, I_BMOD, I_NORMG, I_WIN, I_BIF, I_LNG, I_LNB, I_WSGU, I_BSGU, I_MNG, I_WPOOL, I_PSCALE, I_WBRA, I_WBRB, I_WBRC, I_WOUT, I_FNG };

DI void transpose_item(const float* W, int ldw, int K, bf16_t* WT, int src_col0, int dst_row0, int k0, LAS float* scr, int lane) {
    float tv[32];
#pragma unroll
    for (int i = 0; i < 32; ++i) tv[i] = W[(size_t)(k0 + 2 * i + (lane >> 5)) * ldw + src_col0 + (lane & 31)];
#pragma unroll
    for (int i = 0; i < 32; ++i) scr[(2 * i + (lane >> 5)) * 33 + (lane & 31)] = tv[i];
    asm volatile("s_waitcnt lgkmcnt(0)" ::: "memory");
    const int c = lane & 7;
#pragma unroll
    for (int j = 0; j < 4; ++j) { const int n = (lane >> 3) + 8 * j; const LAS float* s = scr + (8 * c) * 33 + n;
        u32x4 o; o.x = pk2(s[0 * 33], s[1 * 33]); o.y = pk2(s[2 * 33], s[3 * 33]); o.z = pk2(s[4 * 33], s[5 * 33]); o.w = pk2(s[6 * 33], s[7 * 33]);
        *(GAS u32x4*)(WT + (size_t)(dst_row0 + n) * K + k0 + 8 * c) = o; }
    asm volatile("s_waitcnt lgkmcnt(0)" ::: "memory");
}

DI void transpose_item3(const float* W, bf16_t* WT, int n0, int k0, LAS float* scr, int lane) {
    float tv[32];
#pragma unroll
    for (int i = 0; i < 32; ++i) tv[i] = W[(size_t)(k0 + 2 * i + (lane >> 5)) * D + n0 + (lane & 31)];
#pragma unroll
    for (int i = 0; i < 32; ++i) scr[(2 * i + (lane >> 5)) * 33 + (lane & 31)] = tv[i];
    asm volatile("s_waitcnt lgkmcnt(0)" ::: "memory");
    const int c = lane & 7;
#pragma unroll
    for (int j = 0; j < 4; ++j) { const int n = (lane >> 3) + 8 * j; const LAS float* sp = scr + (8 * c) * 33 + n;
        u32x4 o; o.x = pk2(sp[0 * 33], sp[1 * 33]); o.y = pk2(sp[2 * 33], sp[3 * 33]); o.z = pk2(sp[4 * 33], sp[5 * 33]); o.w = pk2(sp[6 * 33], sp[7 * 33]);
        bf16_t* dst = WT + (size_t)(n0 + n) * 3072 + k0 + 8 * c;
        *(u32x4*)dst = o; *(GAS u32x4*)(dst + 1024) = o; *(GAS u32x4*)(dst + 2048) = o; }
    asm volatile("s_waitcnt lgkmcnt(0)" ::: "memory");
}

DI void phase_prologue(const Params& P, ldsp lds, int G) {
    int tid_ = threadIdx.x; asm volatile("" : "+v"(tid_));
    const int tid = tid_, lane = tid & 63, wave = __builtin_amdgcn_readfirstlane(tid >> 6);
    unsigned char* ws = P.ws; asm volatile("" : "+s"(ws));
    LAS float* scr = (LAS float*)(lds + wave * 8448);
    const int gw = blockIdx.x * 8 + wave, NGW = G * 8;
    constexpr int I_IN = 16 * 416, I_BR = 16 * 32;
    constexpr int NIT = 2 * I_IN + 6 * I_BR + 2 * I_BR;
    for (int it = gw; it < NIT; it += NGW) {
        int r = it;
        if (r < 2 * I_IN) { const int l = r / I_IN; r -= l * I_IN; const int kb = r / 416, nb = r % 416; const int n0 = nb * 32; const int sc = n0 + (n0 >= 11264 ? 8 : 0);
            transpose_item(P.in[I_WIN] + (size_t)l * D * NIN, NIN, D, (bf16_t*)(ws + WS_WIN) + (size_t)l * NPROJ * D, sc, n0, kb * 64, scr, lane); continue; }
        r -= 2 * I_IN;
        if (r < 6 * I_BR) { const int lb = r / I_BR; r -= lb * I_BR; const int l = lb / 3, br = lb % 3; const int kb = r / 32, nb = r % 32;
            const float* W = P.in[I_WBRA + br] + (size_t)l * D * D;
            transpose_item(W, D, D, (bf16_t*)(ws + WS_WBR) + (size_t)lb * D * D, nb * 32, nb * 32, kb * 64, scr, lane); continue; }
        r -= 6 * I_BR;
        { const int l = r / I_BR; r -= l * I_BR; const int kb = r / 32, nb = r % 32;
            transpose_item3(P.in[I_WOUT] + (size_t)l * D * D, (bf16_t*)(ws + WS_WOUT3) + (size_t)l * D * 3072, nb * 32, kb * 64, scr, lane); }
    }
    for (int e = blockIdx.x * 512 + tid; e < 2 * 8 * 1024; e += G * 512) { const int l = e >> 13, j = (e >> 10) & 7, k = e & 1023;
        ((float*)(ws + WS_WIF))[e] = P.in[I_WIN][(size_t)l * D * NIN + (size_t)k * NIN + 11264 + j]; }
    __syncthreads();
    LAS float* sc = (LAS float*)lds;
    LAS float* RED = (LAS float*)(lds + 82944);
    for (int e = tid; e < 160 * 129; e += 512) sc[e] = 0.f;
    const int h5 = lane >> 5, r5 = lane & 31;
    for (int it = blockIdx.x; it < 192; it += G) {
        const int l = it / 96, n0 = (it % 96) * 32;
        const float* Wm = P.in[I_WMOD] + (size_t)l * D * 3072 + n0 + r5;
        f32x16 acc[5];
#pragma unroll
        for (int rt = 0; rt < 5; ++rt)
#pragma unroll
            for (int r = 0; r < 16; ++r) acc[rt][r] = 0.f;
        __syncthreads();
        float bq[8];
#pragma unroll
        for (int ks = 0; ks < 8; ++ks) bq[ks] = Wm[(size_t)(wave * 16 + 2 * ks + h5) * 3072];
#pragma unroll 1
        for (int kc = 0; kc < 8; ++kc) {
            __syncthreads();
            for (int e = tid; e < NB * 128; e += 512) { const int r = e >> 7, kk = e & 127; const float cv = (r < PB) ? P.in[I_CP][r * D + kc * 128 + kk] : P.in[I_CS][(r - PB) * D + kc * 128 + kk]; sc[r * 129 + kk] = cv * sigm(cv); }
            __syncthreads();
            float bc[8];
#pragma unroll
            for (int ks = 0; ks < 8; ++ks) bc[ks] = bq[ks];
            if (kc < 7) {
#pragma unroll
                for (int ks = 0; ks < 8; ++ks) bq[ks] = Wm[(size_t)((kc + 1) * 128 + wave * 16 + 2 * ks + h5) * 3072]; }
#pragma unroll
            for (int ks = 0; ks < 8; ++ks) {
                const int kl = wave * 16 + 2 * ks + h5;
#pragma unroll
                for (int rt = 0; rt < 5; ++rt) { const float a = sc[(32 * rt + r5) * 129 + kl]; acc[rt] = __builtin_amdgcn_mfma_f32_32x32x2f32(a, bc[ks], acc[rt], 0, 0, 0); }
            }
        }
        for (int w = 0; w < 8; ++w) {
            if (wave == w) {
#pragma unroll
                for (int rt = 0; rt < 5; ++rt)
#pragma unroll
                    for (int r = 0; r < 16; ++r) { LAS float* p = RED + (32 * rt + crow(r, h5)) * 32 + r5; *p = (w == 0 ? 0.f : *p) + acc[rt][r]; } }
            __syncthreads();
        }
        for (int e = tid; e < NB * 32; e += 512) { const int r = e >> 5, cn = e & 31; ((float*)(ws + WS_MOD))[((size_t)l * NB + r) * 3072 + n0 + cn] = RED[e] + P.in[I_BMOD][l * 3072 + n0 + cn]; }
    }
    __syncthreads();
}

DI void phase_norm(const Params& P, ldsp lds, int G, int l) {
    int tid_ = threadIdx.x; asm volatile("" : "+v"(tid_));
    const int tid = tid_, lane = tid & 63, wave = __builtin_amdgcn_readfirstlane(tid >> 6);
    unsigned char* ws = P.ws; asm volatile("" : "+s"(ws));
    LAS float* wif = (LAS float*)lds;
    for (int e = tid; e < 8192; e += 512) wif[e] = ((const float*)(ws + WS_WIF))[l * 8192 + e];
    __syncthreads();
    const float* X1 = (const float*)(ws + WS_X1);
    const float* mod = (const float*)(ws + WS_MOD) + (size_t)l * NB * 3072;
    const float* ng = P.in[I_NORMG] + l * D;
    f32x4 vn[4];
    {   const int row = blockIdx.x * 8 + wave;
        const float* xr = (row >= MP) ? P.in[I_XS] + (size_t)(row - MP) * D : (l == 0 ? P.in[I_XP] + (size_t)row * D : X1 + (size_t)row * D);
#pragma unroll
        for (int j = 0; j < 4; ++j) vn[j] = ((const GAS f32x4*)xr)[lane + 64 * j]; }
    for (int row = blockIdx.x * 8 + wave; row < M; row += G * 8) {
        f32x4 v[4]; float ss = 0.f;
#pragma unroll
        for (int j = 0; j < 4; ++j) v[j] = vn[j];
        {   const int rown = row + G * 8;
            if (rown < M) { const float* xr = (rown >= MP) ? P.in[I_XS] + (size_t)(rown - MP) * D : (l == 0 ? P.in[I_XP] + (size_t)rown * D : X1 + (size_t)rown * D);
#pragma unroll
                for (int j = 0; j < 4; ++j) vn[j] = ((const GAS f32x4*)xr)[lane + 64 * j]; } }
        if (l == 1 && row >= MP) {
            const float* po = (const float*)(ws + WS_PO) + (size_t)(row - MP) * D; float* xo = (float*)(ws + WS_X1) + (size_t)row * D;
#pragma unroll
            for (int j = 0; j < 4; ++j) { v[j] += ((const GAS f32x4*)po)[lane + 64 * j] + ((const GAS f32x4*)(po + (size_t)MS * D))[lane + 64 * j] + ((const GAS f32x4*)(po + 2 * (size_t)MS * D))[lane + 64 * j]; ((GAS f32x4*)xo)[lane + 64 * j] = v[j]; } }
#pragma unroll
        for (int j = 0; j < 4; ++j) ss += v[j][0] * v[j][0] + v[j][1] * v[j][1] + v[j][2] * v[j][2] + v[j][3] * v[j][3];
        const float rms = rsqrtf(wave_sum(ss) * (1.f / D) + EPS);
        const float* mr = mod + (size_t)mod_row(row) * 3072;
        float gd[8];
#pragma unroll
        for (int q = 0; q < 8; ++q) gd[q] = 0.f;
#pragma unroll
        for (int j = 0; j < 4; ++j) {
            const int e = 4 * (lane + 64 * j);
            const f32x4 g4 = *(const GAS f32x4*)(ng + e), sh = *(const GAS f32x4*)(mr + e), scl = *(const GAS f32x4*)(mr + 1024 + e);
            f32x4 hv = (v[j] * rms) * g4 * (scl + 1.f) + sh;
            u32x2 o; o.x = pk2(hv[0], hv[1]); o.y = pk2(hv[2], hv[3]);
            *(GAS u32x2*)((bf16_t*)(ws + WS_H) + (size_t)row * D + e) = o;
#pragma unroll
            for (int q = 0; q < 8; ++q) { const f32x4 w4 = *(const LAS f32x4*)(wif + q * 1024 + e); gd[q] += hv[0] * w4[0] + hv[1] * w4[1] + hv[2] * w4[2] + hv[3] * w4[3]; }
        }
#pragma unroll
        for (int q = 0; q < 8; ++q) gd[q] = wave_sum(gd[q]);
        if (lane < 8) { float val = gd[0];
#pragma unroll
            for (int q = 1; q < 8; ++q) val = (lane == q) ? gd[q] : val;
            ((float*)(ws + WS_GIF))[(size_t)row * 8 + lane] = val + P.in[I_BIF][l * 8 + lane]; }
    }
    __syncthreads();
}

DI float log_sigmoid(float x) { return fminf(x, 0.f) - log1pf(__expf(-fabsf(x))); }

constexpr int TS = 528;
constexpr int XS = 576;
DI void scan_item(const Params& P, ldsp lds, int l, int it) {
    int tid_ = threadIdx.x; asm volatile("" : "+v"(tid_));
    const int tid = tid_, lane = tid & 63, wave = __builtin_amdgcn_readfirstlane(tid >> 6);
    unsigned char* ws = P.ws; asm volatile("" : "+s"(ws));
    const int bh = it >> 3, sl = it & 7, b = bh >> 2, hh = bh & 3;
    const int row0 = b * PT;
    const ldsp KT = lds;
    const ldsp VT = lds + 73728;
    LAS float* GA = (LAS float*)(lds + 81920);
    LAS float* GB = GA + 2048;
    LAS float* GC = GB + 2048;
    LAS float* CH = GC + 2048;
    LAS float* WE = CH + 96;
    const float* gif = (const float*)(ws + WS_GIF);
    const bf16_t* proj = (const bf16_t*)(ws + WS_PROJ);
    __syncthreads();
#pragma unroll
    for (int cc = 0; cc < 2; ++cc) {
        const int c = 2 * wave + cc; const size_t r = (size_t)(row0 + c * 128 + 2 * lane);
        const float i0 = gif[r * 8 + hh], i1 = gif[(r + 1) * 8 + hh];
        const float f0 = log_sigmoid(gif[r * 8 + 4 + hh]), f1 = log_sigmoid(gif[(r + 1) * 8 + 4 + hh]);
        float s = f0 + f1;
#pragma unroll
        for (int o = 1; o < 64; o <<= 1) { const float t = __shfl_up(s, o); if (lane >= o) s += t; }
        const float b1 = s, b0 = s - f1, a0 = i0 - b0, a1 = i1 - b1;
        float pm = fmaxf(a0, a1);
#pragma unroll
        for (int o = 1; o < 64; o <<= 1) { const float t = __shfl_up(pm, o); if (lane >= o) pm = fmaxf(pm, t); }
        float ex = __shfl_up(pm, 1); if (lane == 0) ex = -INFINITY;
        GA[c * 128 + 2 * lane] = a0; GA[c * 128 + 2 * lane + 1] = a1;
        GB[c * 128 + 2 * lane] = b0; GB[c * 128 + 2 * lane + 1] = b1;
        GC[c * 128 + 2 * lane] = fmaxf(ex, a0); GC[c * 128 + 2 * lane + 1] = pm;
        if (lane == 63) { CH[c] = pm; CH[16 + c] = s; }
    }
    __syncthreads();
    if (tid == 0) { float m = 0.f;
        for (int c = 0; c < 16; ++c) { CH[32 + c] = m; const float Me = fmaxf(m, CH[c]); CH[49 + c] = Me; m = CH[16 + c] + Me; }
        CH[48] = m; }
    __syncthreads();
    if (sl == 0) {
        float* tok = (float*)(ws + WS_TOK);
        for (int idx = tid; idx < 2048; idx += 512) { const int c = idx >> 7; const float mc = CH[32 + c], Mt = fmaxf(mc, GC[idx]);
            tok[(size_t)bh * 2048 + idx] = GA[idx];
            tok[(size_t)(32 + bh) * 2048 + idx] = Mt;
            tok[(size_t)(64 + bh) * 2048 + idx] = __expf(mc - Mt);
            tok[(size_t)(96 + bh) * 2048 + idx] = __expf(-(GB[idx] + Mt)); }
        if (tid == 0) P.out[O_MP + (size_t)l * 32 + bh] = CH[48];
    }
    f32x16 acc;
#pragma unroll
    for (int r = 0; r < 16; ++r) acc[r] = 0.f;
    float nacc = 0.f;
    u32x4 kreg[8]; u32x4 vreg; u32x4 kreg2[8]; u32x4 vreg2;
    const int krow = tid >> 5, kcc = tid & 31, vrow = tid >> 2, vcc = tid & 3;
    {   const bf16_t* base = proj + (size_t)row0 * NPROJ;
#pragma unroll
        for (int i = 0; i < 8; ++i) kreg[i] = *(const GAS u32x4*)(base + (size_t)(krow + 16 * i) * NPROJ + C_K + hh * 256 + kcc * 8);
        vreg = *(const GAS u32x4*)(base + (size_t)vrow * NPROJ + C_V + hh * 256 + sl * 32 + vcc * 8);
        const bf16_t* base1 = base + (size_t)128 * NPROJ;
#pragma unroll
        for (int i = 0; i < 8; ++i) kreg2[i] = *(const GAS u32x4*)(base1 + (size_t)(krow + 16 * i) * NPROJ + C_K + hh * 256 + kcc * 8);
        vreg2 = *(const GAS u32x4*)(base1 + (size_t)vrow * NPROJ + C_V + hh * 256 + sl * 32 + vcc * 8); }
    const int h5 = lane >> 5;
    LAS float* NP = WE + 128;
    float dprev = 0.f;
#define SCAN_CHUNK(CI, KR, VR) do { const int c = (CI); \
        const float Me = CH[49 + c]; \
        if (tid < 32) { if (c > 0) { float s = 0.f; \
        _Pragma("unroll") \
                for (int sg = 0; sg < 16; ++sg) s += NP[sg * 32 + tid]; \
                nacc = dprev * nacc + s; } \
            ((float*)(ws + WS_NST))[(size_t)(bh * NCH + c) * 256 + 32 * sl + tid] = nacc; } \
        _Pragma("unroll") \
        for (int i = 0; i < 8; ++i) *(LAS u32x4*)(KT + (krow + 16 * i) * XS + kcc * 16) = KR[i]; \
        { const float we = __expf(GA[c * 128 + vrow] - Me); float f[8]; unpack8(VR, f); u32x4 o; \
          o.x = pk2(f[0] * we, f[1] * we); o.y = pk2(f[2] * we, f[3] * we); o.z = pk2(f[4] * we, f[5] * we); o.w = pk2(f[6] * we, f[7] * we); \
          *(LAS u32x4*)(VT + vrow * 64 + vcc * 16) = o; } \
        if (tid < 128) WE[tid] = __expf(GA[c * 128 + tid] - Me); \
        __syncthreads(); \
        if (c + 2 < NCH) { const bf16_t* base = proj + (size_t)(row0 + (c + 2) * 128) * NPROJ; \
        _Pragma("unroll") \
            for (int i = 0; i < 8; ++i) KR[i] = *(const GAS u32x4*)(base + (size_t)(krow + 16 * i) * NPROJ + C_K + hh * 256 + kcc * 8); \
            VR = *(const GAS u32x4*)(base + (size_t)vrow * NPROJ + C_V + hh * 256 + sl * 32 + vcc * 8); } \
        { GAS bf16_t* cs = (GAS bf16_t*)(ws + WS_CST) + ((size_t)(bh * NCH + c) * 256) * 256 + sl * 32 + (lane & 31); \
        _Pragma("unroll") \
          for (int r = 0; r < 16; ++r) cs[(size_t)(32 * wave + crow(r, h5)) * 256] = f2bf(acc[r]); } \
        const float decay = __expf(CH[32 + c] - Me); \
        _Pragma("unroll") \
        for (int r = 0; r < 16; ++r) acc[r] *= decay; \
        _Pragma("unroll") \
        for (int kk = 0; kk < 8; ++kk) { const bf16x8 a = frag_tr(KT, XS, 16 * kk, 32 * wave, lane), bb = frag_tr(VT, 64, 16 * kk, 0, lane); acc = MFMA32(a, bb, acc); } \
        { const int dkl = tid & 31, sg = tid >> 5; float s = 0.f; \
        _Pragma("unroll") \
          for (int j = 0; j < 8; ++j) s += WE[8 * sg + j] * bf2f(*(const LAS bf16_t*)(KT + (8 * sg + j) * XS + (32 * sl + dkl) * 2)); \
          NP[sg * 32 + dkl] = s; dprev = decay; } \
        __syncthreads(); \
    } while (0)
    for (int c2 = 0; c2 < NCH; c2 += 2) { SCAN_CHUNK(c2, kreg, vreg); SCAN_CHUNK(c2 + 1, kreg2, vreg2); }
#undef SCAN_CHUNK
    { GAS float* co = (GAS float*)P.out + O_CP + ((size_t)(l * 32 + bh) * 256) * 256 + sl * 32 + (lane & 31);
#pragma unroll
      for (int r = 0; r < 16; ++r) co[(size_t)(32 * wave + crow(r, h5)) * 256] = acc[r]; }
    if (tid < 32) { float s = 0.f;
#pragma unroll
        for (int sg = 0; sg < 16; ++sg) s += NP[sg * 32 + tid];
        P.out[O_NP + (size_t)(l * 32 + bh) * 256 + 32 * sl + tid] = dprev * nacc + s; }
}

DI void sample_mlstm_item(const Params& P, ldsp lds, int l, int it) {
    int tid_ = threadIdx.x; asm volatile("" : "+v"(tid_));
    const int tid = tid_, lane = tid & 63, wave = __builtin_amdgcn_readfirstlane(tid >> 6);
    unsigned char* ws = P.ws; asm volatile("" : "+s"(ws));
    const int b = it >> 2, hh = it & 3;
    const int row0 = MP + b * 8;
    LAS float* QS = (LAS float*)lds;
    LAS float* KS = QS + 2048;
    LAS float* KW = KS + 2048;
    LAS float* PS = KW + 2048;
    LAS float* QN = PS + 64;
    LAS float* RED = QN + 64;
    const float* gif = (const float*)(ws + WS_GIF);
    const bf16_t* proj = (const bf16_t*)(ws + WS_PROJ);
    const size_t sidx = (size_t)(l * SB + b) * 4 + hh;
    const float m0 = P.in[I_SM][sidx];
    bf16_t qraw[4], kraw[4];
#pragma unroll
    for (int i = 0; i < 4; ++i) { const int e = tid + 512 * i, t = e >> 8, dk = e & 255;
        qraw[i] = proj[(size_t)(row0 + t) * NPROJ + C_Q + hh * 256 + dk]; kraw[i] = proj[(size_t)(row0 + t) * NPROJ + C_K + hh * 256 + dk]; }
    f32x4 v[8];
#pragma unroll
    for (int s = 0; s < 8; ++s) { const u32x2 w = *(const GAS u32x2*)(proj + (size_t)(row0 + s) * NPROJ + C_V + hh * 256 + 4 * lane); v[s] = (f32x4){bf_lo(w.x), bf_hi(w.x), bf_lo(w.y), bf_hi(w.y)}; }
    float ig[8], bc[8], a[8], Mt[8];
    { float s = 0.f, cm = -INFINITY;
#pragma unroll
      for (int t = 0; t < 8; ++t) { ig[t] = gif[(size_t)(row0 + t) * 8 + hh]; s += log_sigmoid(gif[(size_t)(row0 + t) * 8 + 4 + hh]); bc[t] = s; a[t] = ig[t] - s; cm = fmaxf(cm, a[t]); Mt[t] = fmaxf(m0, cm); } }
    const float Mend = Mt[7], decay = __expf(m0 - Mend), mnew = bc[7] + Mend;
    float wexp[8];
#pragma unroll
    for (int s = 0; s < 8; ++s) wexp[s] = __expf(a[s] - Mend);
    __syncthreads();
#pragma unroll
    for (int i = 0; i < 4; ++i) { const int e = tid + 512 * i, t = e >> 8, dk = e & 255;
        const float qv = bf2f(qraw[i]), kv = bf2f(kraw[i]);
        float we = 0.f;
#pragma unroll
        for (int s = 0; s < 8; ++s) we = (t == s) ? wexp[s] : we;
        QS[dk * 8 + t] = qv; KS[dk * 8 + t] = kv; KW[dk * 8 + t] = kv * we; }
    __syncthreads();
    const float* n0 = P.in[I_SN] + sidx * 256;
    {
        const int pr = tid >> 3, t = pr >> 3, s = pr & 7, ch = tid & 7; float d = 0.f;
#pragma unroll 4
        for (int dk = 32 * ch; dk < 32 * ch + 32; ++dk) d += QS[dk * 8 + t] * KS[dk * 8 + s];
        d += __shfl_xor(d, 1); d += __shfl_xor(d, 2); d += __shfl_xor(d, 4);
        float as = 0.f, mt = 0.f;
#pragma unroll
        for (int j = 0; j < 8; ++j) { as = (s == j) ? a[j] : as; mt = (t == j) ? Mt[j] : mt; }
        const float pw = d * __expf(as - mt);
        if (ch == 0) PS[pr] = (s <= t) ? pw : 0.f; }
    if (tid < 64) { const int t = tid >> 3, ch = tid & 7; float d = 0.f;
#pragma unroll 4
        for (int dk = 32 * ch; dk < 32 * ch + 32; ++dk) d += QS[dk * 8 + t] * n0[dk];
        d += __shfl_xor(d, 1); d += __shfl_xor(d, 2); d += __shfl_xor(d, 4);
        if (ch == 0) QN[t] = d; }
    f32x4 hc[8];
#pragma unroll
    for (int t = 0; t < 8; ++t) hc[t] = (f32x4){0.f, 0.f, 0.f, 0.f};
    const float* C0 = P.in[I_SC] + sidx * 65536;
    float* Cn = P.out + O_CS + sidx * 65536;
    for (int i = 0; i < 32; i += 8) {
        f32x4 cv[8];
#pragma unroll
        for (int u = 0; u < 8; ++u) cv[u] = __builtin_nontemporal_load((const GAS f32x4*)(C0 + (size_t)(wave + 8 * (i + u)) * 256) + lane);
#pragma unroll
        for (int u = 0; u < 8; ++u) { const int dk = wave + 8 * (i + u);
            const f32x4 q0 = *(const LAS f32x4*)(QS + dk * 8), q1 = *(const LAS f32x4*)(QS + dk * 8 + 4), k0 = *(const LAS f32x4*)(KW + dk * 8), k1 = *(const LAS f32x4*)(KW + dk * 8 + 4);
            f32x4 cn = cv[u] * decay;
            cn += v[0] * k0[0]; cn += v[1] * k0[1]; cn += v[2] * k0[2]; cn += v[3] * k0[3]; cn += v[4] * k1[0]; cn += v[5] * k1[1]; cn += v[6] * k1[2]; cn += v[7] * k1[3];
            __builtin_nontemporal_store(cn, (GAS f32x4*)(Cn + (size_t)dk * 256) + lane);
            hc[0] += cv[u] * q0[0]; hc[1] += cv[u] * q0[1]; hc[2] += cv[u] * q0[2]; hc[3] += cv[u] * q0[3]; hc[4] += cv[u] * q1[0]; hc[5] += cv[u] * q1[1]; hc[6] += cv[u] * q1[2]; hc[7] += cv[u] * q1[3]; }
    }
#pragma unroll
    for (int t = 0; t < 8; ++t) *(LAS f32x4*)(RED + (wave * 8 + t) * 256 + 4 * lane) = hc[t];
    __syncthreads();
    {
        const int t = wave; f32x4 s = (f32x4){0.f, 0.f, 0.f, 0.f};
#pragma unroll
        for (int w = 0; w < 8; ++w) s += *(const LAS f32x4*)(RED + (w * 8 + t) * 256 + 4 * lane);
        float mt = 0.f, bt = 0.f;
#pragma unroll
        for (int j = 0; j < 8; ++j) { mt = (t == j) ? Mt[j] : mt; bt = (t == j) ? bc[j] : bt; }
        const float wi = __expf(m0 - mt);
        f32x4 num = s * wi; float den = wi * QN[t];
#pragma unroll
        for (int sI = 0; sI < 8; ++sI) { const float p = PS[t * 8 + sI]; num += v[sI] * p; den += p; }
        const float dd = fmaxf(fabsf(den), __expf(-(bt + mt)));
        const size_t row = (size_t)(row0 + t);
        const u32x2 ow = *(const GAS u32x2*)(proj + row * NPROJ + C_OB + hh * 256 + 4 * lane), zw = *(const GAS u32x2*)(proj + row * NPROJ + C_ZB + hh * 256 + 4 * lane);
        f32x4 hb = num * (1.f / dd) * (f32x4){bf_lo(ow.x), bf_hi(ow.x), bf_lo(ow.y), bf_hi(ow.y)};
        const float mu = wave_sum(hb[0] + hb[1] + hb[2] + hb[3]) * (1.f / 256.f);
        const f32x4 dv = hb - mu;
        const float rstd = rsqrtf(wave_sum(dv[0] * dv[0] + dv[1] * dv[1] + dv[2] * dv[2] + dv[3] * dv[3]) * (1.f / 256.f) + EPS);
        const f32x4 g4 = *(const GAS f32x4*)(P.in[I_MNG] + l * D + hh * 256 + 4 * lane);
        const f32x4 y = dv * rstd * g4 * (f32x4){bf_lo(zw.x), bf_hi(zw.x), bf_lo(zw.y), bf_hi(zw.y)};
        u32x2 o; o.x = pk2(y[0], y[1]); o.y = pk2(y[2], y[3]);
        *(GAS u32x2*)((bf16_t*)(ws + WS_Y) + ((size_t)M + row) * D + hh * 256 + 4 * lane) = o;
    }
    if (tid < 256) { float s = 0.f;
#pragma unroll
        for (int j = 0; j < 8; ++j) s += KW[tid * 8 + j];
        P.out[O_NS + sidx * 256 + tid] = decay * n0[tid] + s; }
    if (tid == 0) P.out[O_MS + sidx] = mnew;
    __syncthreads();
}

DI void lnstats_rows(const Params& P, int G) {
    int tid_ = threadIdx.x; asm volatile("" : "+v"(tid_));
    const int tid = tid_, lane = tid & 63, wave = __builtin_amdgcn_readfirstlane(tid >> 6);
    const bf16_t* proj = (const bf16_t*)(P.ws + WS_PROJ);
    for (int row0 = blockIdx.x * 8 + wave; row0 < MP; row0 += G * 8 * 4) {
        u32x4 ra[4], rb[4];
#pragma unroll
        for (int k = 0; k < 4; ++k) { const int row = row0 + k * G * 8; if (row < MP) { ra[k] = *(const GAS u32x4*)(proj + (size_t)row * NPROJ + C_VA + 8 * lane); rb[k] = *(const GAS u32x4*)(proj + (size_t)row * NPROJ + C_VA + 512 + 8 * lane); } }
#pragma unroll
        for (int k = 0; k < 4; ++k) { const int row = row0 + k * G * 8; if (row < MP) {
            float f[16]; unpack8(ra[k], f); unpack8(rb[k], f + 8);
            float sm = 0.f;
#pragma unroll
            for (int j = 0; j < 16; ++j) sm += f[j];
            const float mu = wave_sum(sm) * (1.f / D); float q = 0.f;
#pragma unroll
            for (int j = 0; j < 16; ++j) { const float d = f[j] - mu; q += d * d; }
            const float rstd = rsqrtf(wave_sum(q) * (1.f / D) + EPS);
            if (lane == 0) *(GAS f32x2*)((float*)(P.ws + WS_LNS) + (size_t)row * 2) = (f32x2){mu, rstd}; } }
    }
}

DI void pool_prompt_item(const Params& P, int l, int it) {
    int tid_ = threadIdx.x; asm volatile("" : "+v"(tid_));
    const int tid = tid_;
    const bf16_t* proj = (const bf16_t*)(P.ws + WS_PROJ);
    const int cc = tid & 127, tq = tid >> 7, w = 2 << (cc >> 5);
    const int g0 = it * 64 + tq * 16;
    const int t0 = g0 & (PT - 1), b = g0 >> 11;
    const bf16_t* base = proj + (size_t)g0 * NPROJ + C_P + cc * 8;
    u32x4 rw[31];
#pragma unroll
    for (int j = 0; j < 15; ++j) { rw[j] = (u32x4){0u, 0u, 0u, 0u}; if (t0 > 0 && 15 - j < w) rw[j] = *(const GAS u32x4*)(base - (ptrdiff_t)(15 - j) * NPROJ); }
#pragma unroll
    for (int j = 15; j < 31; ++j) rw[j] = *(const GAS u32x4*)(base + (size_t)(j - 15) * NPROJ);
    float sum[8];
#pragma unroll
    for (int e = 0; e < 8; ++e) sum[e] = 0.f;
#pragma unroll
    for (int j = 0; j < 15; ++j) { float f[8]; unpack8(rw[j], f);
#pragma unroll
        for (int e = 0; e < 8; ++e) sum[e] += f[e]; }
#pragma unroll
    for (int i = 0; i < 16; ++i) {
        const int t = t0 + i; float f[8]; unpack8(rw[15 + i], f);
        const float inv = 1.f / (float)min(t + 1, w);
        float o[8];
#pragma unroll
        for (int e = 0; e < 8; ++e) { sum[e] += f[e]; o[e] = sum[e] * inv - f[e]; }
        u32x4 ow; ow.x = pk2(o[0], o[1]); ow.y = pk2(o[2], o[3]); ow.z = pk2(o[4], o[5]); ow.w = pk2(o[6], o[7]);
        *(GAS u32x4*)((bf16_t*)(P.ws + WS_POOLED) + (size_t)(g0 + i) * D + cc * 8) = ow;
        if (t >= PT - 15) { float* po = P.out + O_PP + ((size_t)(l * PB + b) * 15 + (t - (PT - 15))) * 1024 + cc * 8;
            *(f32x4*)po = (f32x4){f[0], f[1], f[2], f[3]}; *(GAS f32x4*)(po + 4) = (f32x4){f[4], f[5], f[6], f[7]}; }
        const u32x4 lv = (w == 2) ? rw[14 + i] : (w == 4) ? rw[12 + i] : (w == 8) ? rw[8 + i] : rw[i];
        float f2[8]; unpack8(lv, f2);
#pragma unroll
        for (int e = 0; e < 8; ++e) sum[e] -= f2[e];
    }
}
DI void pool_sample_item(const Params& P, int l, int it) {
    int tid_ = threadIdx.x; asm volatile("" : "+v"(tid_));
    const int tid = tid_;
    const bf16_t* proj = (const bf16_t*)(P.ws + WS_PROJ);
    const int cc = tid & 127, b = it * 4 + (tid >> 7), w = 2 << (cc >> 5);
    const float* buf = P.in[I_SP] + ((size_t)(l * SB + b) * 15) * 1024 + cc * 8;
    const int row0 = MP + b * 8;
    f32x4 fb[15][2]; u32x4 pr[8];
#pragma unroll
    for (int j = 0; j < 15; ++j) { fb[j][0] = (f32x4){0.f, 0.f, 0.f, 0.f}; fb[j][1] = fb[j][0];
        if (j >= 8 || w == 16) { fb[j][0] = *(const GAS f32x4*)(buf + (size_t)j * 1024); fb[j][1] = *(const GAS f32x4*)(buf + (size_t)j * 1024 + 4); } }
#pragma unroll
    for (int t = 0; t < 8; ++t) pr[t] = *(const GAS u32x4*)(proj + (size_t)(row0 + t) * NPROJ + C_P + cc * 8);
    float* po = P.out + O_PS + ((size_t)(l * SB + b) * 15) * 1024 + cc * 8;
#pragma unroll
    for (int i = 0; i < 7; ++i) { *(GAS f32x4*)(po + (size_t)i * 1024) = fb[8 + i][0]; *(GAS f32x4*)(po + (size_t)i * 1024 + 4) = fb[8 + i][1]; }
    float full[23][8];
#pragma unroll
    for (int j = 0; j < 15; ++j) { full[j][0] = fb[j][0][0]; full[j][1] = fb[j][0][1]; full[j][2] = fb[j][0][2]; full[j][3] = fb[j][0][3]; full[j][4] = fb[j][1][0]; full[j][5] = fb[j][1][1]; full[j][6] = fb[j][1][2]; full[j][7] = fb[j][1][3]; }
#pragma unroll
    for (int t = 0; t < 8; ++t) unpack8(pr[t], full[15 + t]);
    float sum[8];
#pragma unroll
    for (int e = 0; e < 8; ++e) sum[e] = 0.f;
#pragma unroll
    for (int j = 0; j < 15; ++j) { const bool in = (15 - j) < w;
#pragma unroll
        for (int e = 0; e < 8; ++e) sum[e] += in ? full[j][e] : 0.f; }
    const float inv = 1.f / (float)w;
#pragma unroll
    for (int t = 0; t < 8; ++t) {
        float o[8];
#pragma unroll
        for (int e = 0; e < 8; ++e) { sum[e] += full[15 + t][e]; o[e] = sum[e] * inv - full[15 + t][e]; }
        u32x4 ow; ow.x = pk2(o[0], o[1]); ow.y = pk2(o[2], o[3]); ow.z = pk2(o[4], o[5]); ow.w = pk2(o[6], o[7]);
        *(GAS u32x4*)((bf16_t*)(P.ws + WS_POOLED) + (size_t)(row0 + t) * D + cc * 8) = ow;
        *(GAS f32x4*)(po + (size_t)(7 + t) * 1024) = (f32x4){full[15 + t][0], full[15 + t][1], full[15 + t][2], full[15 + t][3]};
        *(GAS f32x4*)(po + (size_t)(7 + t) * 1024 + 4) = (f32x4){full[15 + t][4], full[15 + t][5], full[15 + t][6], full[15 + t][7]};
#pragma unroll
        for (int e = 0; e < 8; ++e) { const float lv = (w == 2) ? full[14 + t][e] : (w == 4) ? full[12 + t][e] : (w == 8) ? full[8 + t][e] : full[t][e]; sum[e] -= lv; }
    }
}

DI void sgu_sample_item(const Params& P, ldsp lds, int l, int b) {
    int tid_ = threadIdx.x; asm volatile("" : "+v"(tid_));
    const int tid = tid_, lane = tid & 63, wave = __builtin_amdgcn_readfirstlane(tid >> 6);
    const bf16_t* proj = (const bf16_t*)(P.ws + WS_PROJ);
    LAS float* VS = (LAS float*)lds;
    __syncthreads();
    const size_t row = (size_t)(MP + b * 8 + wave);
    {   float f[16];
        unpack8(*(const GAS u32x4*)(proj + row * NPROJ + C_VA + 8 * lane), f); unpack8(*(const GAS u32x4*)(proj + row * NPROJ + C_VA + 512 + 8 * lane), f + 8);
        float s = 0.f;
#pragma unroll
        for (int j = 0; j < 16; ++j) s += f[j];
        const float mu = wave_sum(s) * (1.f / D); float q = 0.f;
#pragma unroll
        for (int j = 0; j < 16; ++j) { const float d = f[j] - mu; q += d * d; }
        const float rstd = rsqrtf(wave_sum(q) * (1.f / D) + EPS);
        float* vo = P.out + O_VS + ((size_t)(l * SB + b) * 8 + wave) * 1024;
#pragma unroll
        for (int hf = 0; hf < 2; ++hf) { const int c0 = hf * 512 + 8 * lane;
#pragma unroll
            for (int j = 0; j < 8; ++j) { const float y = (f[hf * 8 + j] - mu) * rstd * P.in[I_LNG][l * D + c0 + j] + P.in[I_LNB][l * D + c0 + j]; VS[wave * 1024 + c0 + j] = y; vo[c0 + j] = y; } }
    }
    __syncthreads();
    {   const int i = wave;
#pragma unroll
        for (int hf = 0; hf < 2; ++hf) { const int c0 = hf * 512 + 8 * lane, g = c0 >> 8;
            const float* wrow = P.in[I_WSGU] + ((size_t)(l * 4 + g) * 128 + i) * 128;
            const float bs = P.in[I_BSGU][(l * 4 + g) * 128 + i];
            float s[8];
#pragma unroll
            for (int j = 0; j < 8; ++j) s[j] = bs;
            for (int jj = 0; jj <= i; ++jj) { const float wv = wrow[jj];
#pragma unroll
                for (int j = 0; j < 8; ++j) s[j] += wv * VS[jj * 1024 + c0 + j]; }
            float uu[8], zz[8]; unpack8(*(const GAS u32x4*)(proj + row * NPROJ + C_U + c0), uu); unpack8(*(const GAS u32x4*)(proj + row * NPROJ + C_ZA + c0), zz);
            u32x4 o; o.x = pk2(uu[0] * s[0] * zz[0], uu[1] * s[1] * zz[1]); o.y = pk2(uu[2] * s[2] * zz[2], uu[3] * s[3] * zz[3]);
            o.z = pk2(uu[4] * s[4] * zz[4], uu[5] * s[5] * zz[5]); o.w = pk2(uu[6] * s[6] * zz[6], uu[7] * s[7] * zz[7]);
            *(GAS u32x4*)((bf16_t*)(P.ws + WS_Y) + row * D + c0) = o; }
    }
}

#define TILE_LOAD(regs, src, ld) do { _Pragma("unroll") for (int _i = 0; _i < 8; ++_i) regs[_i] = *(const GAS u32x4*)((src) + (size_t)(krow + 16 * _i) * (ld) + kcc * 8); } while (0)
#define TILE_STORE(regs, dst, stride) do { _Pragma("unroll") for (int _i = 0; _i < 8; ++_i) *(LAS u32x4*)((dst) + (krow + 16 * _i) * (stride) + kcc * 16) = regs[_i]; } while (0)
constexpr int HSS = 260;

DI void sgu_item(const Params& P, ldsp lds, int l, int it) {
    int tid_ = threadIdx.x; asm volatile("" : "+v"(tid_));
    const int tid = tid_, lane = tid & 63, wave = __builtin_amdgcn_readfirstlane(tid >> 6);
    unsigned char* ws = P.ws; asm volatile("" : "+s"(ws));
    const bf16_t* proj = (const bf16_t*)(ws + WS_PROJ);
    const int g = it & 3, bn = it >> 2, row0 = bn * 128;
    const ldsp WT = lds + 73728;
    const ldsp VN = lds;
    LAS float* HS = (LAS float*)lds;
    const int krow = tid >> 5, kcc = tid & 31;
    __syncthreads();
    {   const float* W = P.in[I_WSGU] + (size_t)(l * 4 + g) * 16384;
#pragma unroll
        for (int ii = 0; ii < 4; ++ii) { const int id = tid + 512 * ii, i = id >> 4, j0 = (id & 15) * 8;
            const f32x4 a = *(const GAS f32x4*)(W + i * 128 + j0), bq = *(const GAS f32x4*)(W + i * 128 + j0 + 4);
            float f[8] = {a[0], a[1], a[2], a[3], bq[0], bq[1], bq[2], bq[3]};
#pragma unroll
            for (int e = 0; e < 8; ++e) f[e] = (j0 + e <= i) ? f[e] : 0.f;
            u32x4 o; o.x = pk2(f[0], f[1]); o.y = pk2(f[2], f[3]); o.z = pk2(f[4], f[5]); o.w = pk2(f[6], f[7]);
            *(LAS u32x4*)(WT + i * 272 + j0 * 2) = o; }
        const int ch0 = g * 256 + kcc * 8;
        float lg[8], lb[8];
#pragma unroll
        for (int e = 0; e < 8; ++e) { lg[e] = P.in[I_LNG][l * D + ch0 + e]; lb[e] = P.in[I_LNB][l * D + ch0 + e]; }
        const float* lns = (const float*)(ws + WS_LNS);
        u32x4 rv[8]; TILE_LOAD(rv, proj + (size_t)row0 * NPROJ + C_VA + g * 256, NPROJ);
#pragma unroll
        for (int ii = 0; ii < 8; ++ii) { const int r = krow + 16 * ii;
            float f[8]; unpack8(rv[ii], f);
            const f32x2 st = *(const GAS f32x2*)(lns + (size_t)(row0 + r) * 2);
#pragma unroll
            for (int e = 0; e < 8; ++e) f[e] = (f[e] - st[0]) * st[1] * lg[e] + lb[e];
            u32x4 o; o.x = pk2(f[0], f[1]); o.y = pk2(f[2], f[3]); o.z = pk2(f[4], f[5]); o.w = pk2(f[6], f[7]);
            *(LAS u32x4*)(VN + r * XS + kcc * 16) = o; }
    }
    __syncthreads();
    u32x4 ru[8], rz[8];
    TILE_LOAD(ru, proj + (size_t)row0 * NPROJ + C_U + g * 256, NPROJ);
    TILE_LOAD(rz, proj + (size_t)row0 * NPROJ + C_ZA + g * 256, NPROJ);
    const int ib = wave & 3, chh = wave >> 2, h5 = lane >> 5;
    f32x16 acc[4];
#pragma unroll
    for (int tt = 0; tt < 4; ++tt)
#pragma unroll
        for (int r = 0; r < 16; ++r) acc[tt][r] = 0.f;
    for (int kk = 0; kk < 2 * (ib + 1); ++kk) {
        const bf16x8 a = frag_row(WT, 272, 32 * ib, 16 * kk, lane);
#pragma unroll
        for (int tt = 0; tt < 4; ++tt) { const bf16x8 bb = frag_tr(VN, XS, 16 * kk, 128 * chh + 32 * tt, lane); acc[tt] = MFMA32(a, bb, acc[tt]); }
    }
    __syncthreads();
    const float* bsg = P.in[I_BSGU] + (l * 4 + g) * 128;
#pragma unroll
    for (int r = 0; r < 16; ++r) { const int i = 32 * ib + crow(r, h5); const float bs = bsg[i];
#pragma unroll
        for (int tt = 0; tt < 4; ++tt) HS[i * HSS + 128 * chh + 32 * tt + (lane & 31)] = acc[tt][r] + bs; }
    __syncthreads();
    bf16_t* ya = (bf16_t*)(ws + WS_Y);
#pragma unroll
    for (int ii = 0; ii < 8; ++ii) { const int r = krow + 16 * ii;
        const f32x4 s0 = *(const LAS f32x4*)(HS + r * HSS + kcc * 8), s1 = *(const LAS f32x4*)(HS + r * HSS + kcc * 8 + 4);
        float uu[8], zz[8]; unpack8(ru[ii], uu); unpack8(rz[ii], zz);
        u32x4 o; o.x = pk2(uu[0] * s0[0] * zz[0], uu[1] * s0[1] * zz[1]); o.y = pk2(uu[2] * s0[2] * zz[2], uu[3] * s0[3] * zz[3]);
        o.z = pk2(uu[4] * s1[0] * zz[4], uu[5] * s1[1] * zz[5]); o.w = pk2(uu[6] * s1[2] * zz[6], uu[7] * s1[3] * zz[7]);
        *(GAS u32x4*)(ya + (size_t)(row0 + r) * D + g * 256 + kcc * 8) = o; }
}

DI void pool_mix_item(const Params& P, ldsp lds, int l, int it) {
    int tid_ = threadIdx.x; asm volatile("" : "+v"(tid_));
    const int tid = tid_, lane = tid & 63, wave = __builtin_amdgcn_readfirstlane(tid >> 6);
    unsigned char* ws = P.ws; asm volatile("" : "+s"(ws));
    const bf16_t* proj = (const bf16_t*)(ws + WS_PROJ);
    const int g = it & 3, row0 = (it >> 2) * 128;
    const ldsp QT = lds;
    const ldsp XT = lds + 67584;
    LAS float* HS = (LAS float*)lds;
    const int krow = tid >> 5, kcc = tid & 31;
    const float* W = P.in[I_WPOOL] + (size_t)(l * 4 + g) * 65536;
    const bf16_t* pooled = (const bf16_t*)(ws + WS_POOLED);
    __syncthreads();
    u32x4 rq[8], rx[8];
    TILE_LOAD(rq, pooled + (size_t)row0 * D + g * 256, D);
#define WLOAD(half) do { _Pragma("unroll") for (int _i = 0; _i < 8; ++_i) { const float* wp = W + (size_t)((half) * 128 + krow + 16 * _i) * 256 + kcc * 8; \
        const f32x4 a = *(const f32x4*)wp, bq = *(const GAS f32x4*)(wp + 4); rx[_i].x = pk2(a[0], a[1]); rx[_i].y = pk2(a[2], a[3]); rx[_i].z = pk2(bq[0], bq[1]); rx[_i].w = pk2(bq[2], bq[3]); } } while (0)
    WLOAD(0);
    TILE_STORE(rq, QT, TS); TILE_STORE(rx, XT, XS);
    __syncthreads();
    WLOAD(1);
    const int tb = wave & 3, dh = wave >> 2, h5 = lane >> 5;
    f32x16 O[4];
#pragma unroll
    for (int tt = 0; tt < 4; ++tt)
#pragma unroll
        for (int r = 0; r < 16; ++r) O[tt][r] = 0.f;
#pragma unroll 1
    for (int half = 0; half < 2; ++half) {
        if (half == 1) { __syncthreads(); TILE_STORE(rx, XT, XS); __syncthreads();
            TILE_LOAD(rx, proj + (size_t)row0 * NPROJ + C_ZC + g * 256, NPROJ); }
#pragma unroll 2
        for (int kk = 0; kk < 8; ++kk) {
            const bf16x8 a = frag_row(QT, TS, 32 * tb, half * 128 + 16 * kk, lane);
#pragma unroll
            for (int tt = 0; tt < 4; ++tt) { const bf16x8 bb = frag_tr(XT, XS, 16 * kk, 128 * dh + 32 * tt, lane); O[tt] = MFMA32(a, bb, O[tt]); }
        }
    }
#undef WLOAD
    __syncthreads();
#pragma unroll
    for (int tt = 0; tt < 4; ++tt) { const int d = 128 * dh + 32 * tt + (lane & 31); const float ps = P.in[I_PSCALE][l * D + g * 256 + d];
#pragma unroll
        for (int r = 0; r < 16; ++r) HS[(32 * tb + crow(r, h5)) * HSS + d] = O[tt][r] * ps; }
    __syncthreads();
    bf16_t* yc = (bf16_t*)(ws + WS_Y) + 2 * (size_t)M * D;
#pragma unroll
    for (int ii = 0; ii < 8; ++ii) { const int r = krow + 16 * ii;
        const f32x4 s0 = *(const LAS f32x4*)(HS + r * HSS + kcc * 8), s1 = *(const LAS f32x4*)(HS + r * HSS + kcc * 8 + 4);
        float zz[8]; unpack8(rx[ii], zz);
        u32x4 o; o.x = pk2(s0[0] * zz[0], s0[1] * zz[1]); o.y = pk2(s0[2] * zz[2], s0[3] * zz[3]); o.z = pk2(s1[0] * zz[4], s1[1] * zz[5]); o.w = pk2(s1[2] * zz[6], s1[3] * zz[7]);
        *(GAS u32x4*)(yc + (size_t)(row0 + r) * D + g * 256 + kcc * 8) = o; }
}

DI void m3_items(const Params& P, ldsp lds, int l, int G) {
    int tid_ = threadIdx.x; asm volatile("" : "+v"(tid_));
    const int tid = tid_, lane = tid & 63, wave = __builtin_amdgcn_readfirstlane(tid >> 6);
    unsigned char* ws = P.ws; asm volatile("" : "+s"(ws));
    const bf16_t* proj = (const bf16_t*)(ws + WS_PROJ);
    const int krow = tid >> 5, kcc = tid & 31;
    u32x4 rq[8], rx[8];
#pragma unroll 1
    for (int it = blockIdx.x; it < 512; it += G) {
    int ti_ = tid; asm volatile("" : "+v"(ti_));
    const int tid = ti_, lane = tid & 63, krow = tid >> 5, kcc = tid & 31;
    const int bh = it >> 4, c = it & 15, b = bh >> 2, hh = bh & 3;
    const int row0 = b * PT + c * 128;
    const ldsp QT = lds;
    const ldsp XT = lds + 67584;
    LAS float* TA = (LAS float*)(lds + 141312);
    LAS float* TM = TA + 128;
    LAS float* TW = TM + 128;
    LAS float* TF = TW + 128;
    LAS float* TN = TF + 128;
    LAS float* DW = TN + 256;
    LAS float* HS = (LAS float*)lds;
    const bf16_t* prow = proj + (size_t)row0 * NPROJ + hh * 256;
    __syncthreads();
    const float* tok = (const float*)(ws + WS_TOK);
    if (tid < 128) { const size_t o = (size_t)bh * 2048 + c * 128 + tid; TA[tid] = tok[o]; TM[tid] = tok[(size_t)32 * 2048 + o]; TW[tid] = tok[(size_t)64 * 2048 + o]; TF[tid] = tok[(size_t)96 * 2048 + o]; }
    else if (tid < 384) TN[tid - 128] = ((const float*)(ws + WS_NST))[(size_t)(bh * NCH + c) * 256 + tid - 128];
    const bf16_t* cst = (const bf16_t*)(ws + WS_CST) + (size_t)(bh * NCH + c) * 65536;
    TILE_LOAD(rq, prow + C_Q, NPROJ); TILE_LOAD(rx, cst, 256);
    TILE_STORE(rq, QT, TS); TILE_STORE(rx, XT, XS);
    __syncthreads();
    TILE_LOAD(rx, cst + 128 * 256, 256);
    TILE_LOAD(rq, prow + C_K, NPROJ);
    const int tb = wave & 3, dh = wave >> 2, h5 = lane >> 5;
    f32x16 O[4];
#pragma unroll
    for (int tt = 0; tt < 4; ++tt)
#pragma unroll
        for (int r = 0; r < 16; ++r) O[tt][r] = 0.f;
#pragma unroll 1
    for (int half = 0; half < 2; ++half) {
        if (half == 1) { __syncthreads(); TILE_STORE(rx, XT, XS); __syncthreads(); TILE_LOAD(rx, prow + C_V, NPROJ); }
#pragma unroll 2
        for (int kk = 0; kk < 8; ++kk) {
            const bf16x8 a = frag_row(QT, TS, 32 * tb, half * 128 + 16 * kk, lane);
#pragma unroll
            for (int tt = 0; tt < 4; ++tt) { const bf16x8 bb = frag_tr(XT, XS, 16 * kk, 128 * dh + 32 * tt, lane); O[tt] = MFMA32(a, bb, O[tt]); }
        }
    }
#pragma unroll
    for (int r = 0; r < 16; ++r) { const float wi = TW[32 * tb + crow(r, h5)];
#pragma unroll
        for (int tt = 0; tt < 4; ++tt) O[tt][r] *= wi; }
    __syncthreads();
    TILE_STORE(rq, XT, TS);
    __syncthreads();
    bf16x8 pf[4][2];
    float denl = 0.f, qn = 0.f;
    const int tq = 32 * tb + (lane & 31);
    const float Mq = TM[tq];
#pragma unroll
    for (int sb = 0; sb < 4; ++sb) {
        if (sb <= tb) {
            f32x16 S;
#pragma unroll
            for (int r = 0; r < 16; ++r) S[r] = 0.f;
#pragma unroll 2
            for (int kk = 0; kk < 16; ++kk) {
                const bf16x8 a = frag_row(XT, TS, 32 * sb, 16 * kk, lane), bb = frag_row(QT, TS, 32 * tb, 16 * kk, lane);
                S = MFMA32(a, bb, S);
                if (sb == 0) {
#pragma unroll
                    for (int j = 0; j < 8; ++j) qn += bf2f((bf16_t)bb[j]) * TN[16 * kk + 8 * h5 + j]; }
            }
            float pw[16];
#pragma unroll
            for (int r = 0; r < 16; ++r) { const int sp = 32 * sb + crow(r, h5);
                float wgt = __expf(TA[sp] - Mq); wgt = (sp <= tq) ? wgt : 0.f; pw[r] = S[r] * wgt; denl += pw[r]; }
#pragma unroll
            for (int s2 = 0; s2 < 2; ++s2) { u32x4 w; w.x = pk2(pw[8 * s2], pw[8 * s2 + 1]); w.y = pk2(pw[8 * s2 + 2], pw[8 * s2 + 3]); w.z = pk2(pw[8 * s2 + 4], pw[8 * s2 + 5]); w.w = pk2(pw[8 * s2 + 6], pw[8 * s2 + 7]);
                pf[sb][s2] = __builtin_bit_cast(bf16x8, w); }
        }
    }
    qn += __shfl_xor(qn, 32); denl += __shfl_xor(denl, 32);
    __syncthreads();
    TILE_STORE(rx, XT, XS);
    __syncthreads();
#pragma unroll
    for (int sb = 0; sb < 4; ++sb) {
        if (sb <= tb) {
#pragma unroll
            for (int s2 = 0; s2 < 2; ++s2)
#pragma unroll
                for (int tt = 0; tt < 4; ++tt) { const bf16x8 bb = frag_tr_perm(XT, XS, 32 * sb + 16 * s2, 128 * dh + 32 * tt, lane); O[tt] = MFMA32(pf[sb][s2], bb, O[tt]); }
        }
    }
    if (lane < 32) DW[wave * 32 + lane] = TW[tq] * qn + denl;
    float rinv[16];
#pragma unroll
    for (int r = 0; r < 16; ++r) { const int tl = crow(r, h5); const float d = DW[wave * 32 + tl]; rinv[r] = 1.f / fmaxf(fabsf(d), TF[32 * tb + tl]); }
    __syncthreads();
#pragma unroll
    for (int r = 0; r < 16; ++r) { const int t = 32 * tb + crow(r, h5);
#pragma unroll
        for (int tt = 0; tt < 4; ++tt) HS[t * HSS + 128 * dh + 32 * tt + (lane & 31)] = O[tt][r] * rinv[r]; }
    u32x2 gow[16], gzw[16];
#pragma unroll
    for (int i = 0; i < 16; ++i) { const size_t row = (size_t)(row0 + 16 * wave + i);
        gow[i] = *(const GAS u32x2*)(proj + row * NPROJ + C_OB + hh * 256 + 4 * lane); gzw[i] = *(const GAS u32x2*)(proj + row * NPROJ + C_ZB + hh * 256 + 4 * lane); }
    __syncthreads();
    const f32x4 g4 = *(const GAS f32x4*)(P.in[I_MNG] + l * D + hh * 256 + 4 * lane);
#pragma unroll
    for (int i = 0; i < 16; ++i) { const int t = 16 * wave + i; const size_t row = (size_t)(row0 + t);
        const f32x4 hv = *(const LAS f32x4*)(HS + t * HSS + 4 * lane);
        const u32x2 ow = gow[i], zw = gzw[i];
        const f32x4 hb = hv * (f32x4){bf_lo(ow.x), bf_hi(ow.x), bf_lo(ow.y), bf_hi(ow.y)};
        const float mu = wave_sum(hb[0] + hb[1] + hb[2] + hb[3]) * (1.f / 256.f);
        const f32x4 dv = hb - mu;
        const float rstd = rsqrtf(wave_sum(dv[0] * dv[0] + dv[1] * dv[1] + dv[2] * dv[2] + dv[3] * dv[3]) * (1.f / 256.f) + EPS);
        const f32x4 y = dv * rstd * g4 * (f32x4){bf_lo(zw.x), bf_hi(zw.x), bf_lo(zw.y), bf_hi(zw.y)};
        u32x2 o; o.x = pk2(y[0], y[1]); o.y = pk2(y[2], y[3]);
        *(GAS u32x2*)((bf16_t*)(ws + WS_Y) + ((size_t)M + row) * D + hh * 256 + 4 * lane) = o; }
    }
}

DI void phase_final(const Params& P, int G) {
    int tid_ = threadIdx.x; asm volatile("" : "+v"(tid_));
    const int tid = tid_, lane = tid & 63, wave = __builtin_amdgcn_readfirstlane(tid >> 6);
    f32x4 g4[4];
#pragma unroll
    for (int j = 0; j < 4; ++j) g4[j] = *(const GAS f32x4*)(P.in[I_FNG] + 4 * (lane + 64 * j));
    for (int row0 = blockIdx.x * 8 + wave; row0 < M; row0 += G * 8 * 2) {
        f32x4 v[2][4];
#pragma unroll
        for (int k = 0; k < 2; ++k) { const int row = row0 + k * G * 8;
            if (row < MP) {
#pragma unroll
                for (int j = 0; j < 4; ++j) v[k][j] = ((const GAS f32x4*)(P.out + O_Y + (size_t)row * D))[lane + 64 * j]; }
            else if (row < M) { const float* po = (const float*)(P.ws + WS_PO) + (size_t)(row - MP) * D; const float* x1 = (const float*)(P.ws + WS_X1) + (size_t)row * D;
#pragma unroll
                for (int j = 0; j < 4; ++j) v[k][j] = ((const GAS f32x4*)x1)[lane + 64 * j] + ((const GAS f32x4*)po)[lane + 64 * j] + ((const GAS f32x4*)(po + (size_t)MS * D))[lane + 64 * j] + ((const GAS f32x4*)(po + 2 * (size_t)MS * D))[lane + 64 * j]; } }
#pragma unroll
        for (int k = 0; k < 2; ++k) { const int row = row0 + k * G * 8;
            if (row < M) { float ss = 0.f;
#pragma unroll
                for (int j = 0; j < 4; ++j) ss += v[k][j][0] * v[k][j][0] + v[k][j][1] * v[k][j][1] + v[k][j][2] * v[k][j][2] + v[k][j][3] * v[k][j][3];
                const float rms = rsqrtf(wave_sum(ss) * (1.f / D) + EPS);
                float* xr = P.out + O_Y + (size_t)row * D;
#pragma unroll
                for (int j = 0; j < 4; ++j) ((GAS f32x4*)xr)[lane + 64 * j] = v[k][j] * rms * g4[j]; } }
    }
}


#define XB_TMO      128
#define XB_XCNT(j)  (256  + 64 * (j))
#define XB_XSUB(j)  (1280 + 64 * (j))
#define XB_XGEN(j)  (2304 + 64 * (j))
#define XB_TOP      3328
#define XB_TOPGEN   3392
#define XCD_BAR_WORDS 3456
#define XB_SPIN_CAP (1u << 22)
DI unsigned xb_ld(unsigned* p)              { return __hip_atomic_load(p, __ATOMIC_RELAXED, __HIP_MEMORY_SCOPE_AGENT); }
DI unsigned xb_add(unsigned* p, unsigned v) { return __hip_atomic_fetch_add(p, v, __ATOMIC_RELAXED, __HIP_MEMORY_SCOPE_AGENT); }
DI unsigned xb_xcc_id() { return (unsigned)__builtin_amdgcn_s_getreg((3 << 11) | 20) & 0xFu; }
#define XB_SPIN(cond, bar) do { unsigned _sp = 0; while (cond) { __builtin_amdgcn_s_sleep(1); \
    if ((++_sp & 255u) == 0u) { if (xb_ld(&(bar)[XB_TMO])) break; if (_sp > XB_SPIN_CAP) { atomicAdd(&(bar)[XB_TMO], 1u); break; } } } } while (0)
struct XcdBarrier { unsigned* bar; unsigned x; volatile LAS unsigned* st; };
DI XcdBarrier xcd_barrier_post(unsigned* bar, volatile LAS unsigned* st) {
    XcdBarrier b; b.bar = bar; b.x = xb_xcc_id(); b.st = st;
    if (threadIdx.x == 0) (void)xb_add(&bar[XB_XCNT(b.x)], 1u);
    return b;
}
DI void xcd_barrier_complete(unsigned* bar, unsigned x, unsigned& nloc, unsigned& nx) {
    const unsigned G = gridDim.x * gridDim.y * gridDim.z;
    unsigned sum, cnt, mine, sp = 0u;
    for (;;) {
        sum = 0u; cnt = 0u; mine = 0u;
#pragma unroll
        for (unsigned j = 0; j < 16; ++j) { const unsigned c = xb_ld(&bar[XB_XCNT(j)]); sum += c; cnt += (c > 0u) ? 1u : 0u; mine = (j == x) ? c : mine; }
        if (sum == G) break;
        __builtin_amdgcn_s_sleep(1);
        if ((++sp & 255u) == 0u) { if (xb_ld(&bar[XB_TMO])) break; if (sp > XB_SPIN_CAP) { atomicAdd(&bar[XB_TMO], 1u); break; } }
    }
    nloc = mine > 0u ? mine : 1u; nx = cnt > 0u ? cnt : 1u;
}
DI void xcd_barrier(const XcdBarrier& b) {
    asm volatile("s_waitcnt vmcnt(0)" ::: "memory");
    __syncthreads();
    if (threadIdx.x == 0) {
        unsigned* bar = b.bar;
        __builtin_amdgcn_s_waitcnt(0);
        unsigned nloc = b.st[0], nx = b.st[1];
        if (nloc == 0u) { xcd_barrier_complete(bar, b.x, nloc, nx); b.st[0] = nloc; b.st[1] = nx; }
        const unsigned old = xb_add(&bar[XB_XSUB(b.x)], 1u);
        const unsigned gen = old / nloc;
        if (old + 1u == (gen + 1u) * nloc) {
            __builtin_amdgcn_fence(__ATOMIC_RELEASE, "agent");
            asm volatile("s_waitcnt vmcnt(0)" ::: "memory");
            const unsigned og = xb_add(&bar[XB_TOP], 1u);
            const unsigned tg = og / nx;
            if (og + 1u == (tg + 1u) * nx) xb_add(&bar[XB_TOPGEN], 1u);
            else XB_SPIN(xb_ld(&bar[XB_TOPGEN]) == tg, bar);
            __builtin_amdgcn_fence(__ATOMIC_ACQUIRE, "agent");
            xb_add(&bar[XB_XGEN(b.x)], 1u);
            asm volatile("s_waitcnt vmcnt(0)" ::: "memory");
        } else {
            XB_SPIN(xb_ld(&bar[XB_XGEN(b.x)]) == gen, bar);
            __builtin_amdgcn_fence(__ATOMIC_ACQUIRE, "agent");
            asm volatile("s_waitcnt vmcnt(0)" ::: "memory");
        }
    }
    __syncthreads();
}

#ifndef REP_PRO
#define REP_PRO 1
#endif
#ifndef REP_N
#define REP_N 1
#endif
#ifndef REP_G1
#define REP_G1 1
#endif
#ifndef REP_M
#define REP_M 1
#endif
#ifndef REP_S
#define REP_S 1
#endif
#ifndef REP_G3
#define REP_G3 1
#endif
#ifndef REP_G4
#define REP_G4 1
#endif
__global__ void __launch_bounds__(512, 2) fwd_kernel(Params P) {
    extern __shared__ __attribute__((aligned(16))) unsigned char lds_raw[];
    const ldsp lds0 = (ldsp)lds_raw;
    cg::grid_group grid = cg::this_grid();
    const int G = gridDim.x;
    volatile LAS unsigned* MISC = (volatile LAS unsigned*)(lds0 + LDS_BYTES - 64);
    if (threadIdx.x < 16) MISC[threadIdx.x] = 0u;
    __syncthreads();
    const XcdBarrier xbar = xcd_barrier_post((unsigned*)P.ws, MISC);
    const int lo = P.ph_lo, hi = P.ph_hi;
    int ph = 0;
#define RUN(k) (lo <= (k) && (k) < hi)
#define SEAM(k) do { if (RUN(k) && RUN((k) + 1)) xcd_barrier(xbar); } while (0)
    for (int rep = 0; rep < REP_PRO; ++rep) { if (rep) xcd_barrier(xbar);
    if (RUN(0)) phase_prologue(P, lds0, G);
    }
    if (P.ph_hi > 1000) grid.sync();
    SEAM(0);
#pragma unroll 1
    for (int l = 0; l < 2; ++l) {
        ph = 1 + 6 * l;

        for (int rep = 0; rep < REP_N; ++rep) { if (rep) xcd_barrier(xbar);
        if (RUN(ph)) { unsigned char* ws = P.ws; asm volatile("" : "+s"(ws)); ldsp lds = lds0; asm volatile("" : "+s"(lds)); phase_norm(P, lds, G, l); }
        }
        SEAM(ph);
        ++ph;
        for (int rep = 0; rep < REP_G1; ++rep) { if (rep) xcd_barrier(xbar);
        if (RUN(ph)) {
            unsigned char* ws = P.ws; asm volatile("" : "+s"(ws)); ldsp lds = lds0; asm volatile("" : "+s"(lds));
            pg8::Gemm g{(const bf16_t*)(ws + WS_H), (const bf16_t*)(ws + WS_WIN) + (size_t)l * NPROJ * D, D, D, D, 0, 0};
            pg8::Sched S; S.init(M, NPROJ, 1, 0, G, (int)blockIdx.x);
            pg8::EpiProj E{(bf16_t*)(ws + WS_PROJ)};
            pg8::gemm_phase<pg8::EpiProj>(lds, g, S, E);
        }
        }
        SEAM(ph);
        ++ph;
        for (int rep = 0; rep < REP_M; ++rep) { if (rep) xcd_barrier(xbar);
        if (RUN(ph)) {
            unsigned char* ws = P.ws; asm volatile("" : "+s"(ws)); ldsp lds = lds0; asm volatile("" : "+s"(lds));
            {   const int grp = (int)((blockIdx.x >> 6) & 3);
                const int ord = grp == 0 ? 0x210 : grp == 1 ? 0x021 : grp == 2 ? 0x102 : 0x201;
#pragma unroll 1
                for (int pass = 0; pass < 3; ++pass) {
                    const int kind = (ord >> (4 * pass)) & 15;
                    if (kind == 0) {
                        for (int it = blockIdx.x; it < 256; it += G) { const int x = it & 7, j = it >> 3; scan_item(P, lds, l, ((4 * x + (j >> 3)) << 3) + (j & 7)); }
                    } else if (kind == 1) {
                        for (int it = blockIdx.x; it < SB * 4; it += G) sample_mlstm_item(P, lds, l, it);
                    } else {
                        lnstats_rows(P, G);
                        for (int it = blockIdx.x; it < MP / 64; it += G) pool_prompt_item(P, l, it);
                        for (int it = (int)(G - 1 - blockIdx.x); it < SB / 4; it += G) pool_sample_item(P, l, it);
                        for (int it = (int)((blockIdx.x + G - 64) % G); it < SB; it += G) sgu_sample_item(P, lds, l, it);
                    }
                }
            }
            __syncthreads();
        }
        }
        SEAM(ph);
        ++ph;
        for (int rep = 0; rep < REP_S; ++rep) { if (rep) xcd_barrier(xbar);
        if (RUN(ph)) {
            unsigned char* ws = P.ws; asm volatile("" : "+s"(ws)); ldsp lds = lds0; asm volatile("" : "+s"(lds));
            {   const int rot = (int)((blockIdx.x >> 3) % 3);
#pragma unroll 1
                for (int pass = 0; pass < 3; ++pass) {
                    const int kind = (pass + rot) % 3;
                    if (kind == 0) m3_items(P, lds, l, G);
                    else if (kind == 1) { for (int it = blockIdx.x; it < 512; it += G) sgu_item(P, lds, l, it); }
                    else { for (int it = blockIdx.x; it < (M / 128) * 4; it += G) pool_mix_item(P, lds, l, it); }
                }
            }
            __syncthreads();
        }
        }
        SEAM(ph);
        ++ph;
        for (int rep = 0; rep < REP_G3; ++rep) { if (rep) xcd_barrier(xbar);
        if (RUN(ph)) {
            unsigned char* ws = P.ws; asm volatile("" : "+s"(ws)); ldsp lds = lds0; asm volatile("" : "+s"(lds));
            pg8::Gemm g{(const bf16_t*)(ws + WS_Y), (const bf16_t*)(ws + WS_WBR) + (size_t)l * 3 * D * D, D, D, D, (size_t)M * D * 2, (size_t)D * D * 2};
            pg8::Sched S; S.init(MP, D, 3, 3, G, (int)blockIdx.x);
            pg8::EpiMerge E{(bf16_t*)(ws + WS_MERGED), (bf16_t*)(ws + WS_PART), (const bf16_t*)(ws + WS_PROJ)};
            pg8::gemm_phase<pg8::EpiMerge>(lds, g, S, E);
        }
        }
        SEAM(ph);
        ++ph;
        for (int rep = 0; rep < REP_G4; ++rep) { if (rep) xcd_barrier(xbar);
        if (RUN(ph)) {
            unsigned char* ws = P.ws; asm volatile("" : "+s"(ws)); ldsp lds = lds0; asm volatile("" : "+s"(lds));
            const bf16_t* w3 = (const bf16_t*)(ws + WS_WOUT3) + (size_t)l * D * 3072;
            const float* X1 = (const float*)(ws + WS_X1);
            const float* modg = (const float*)(ws + WS_MOD) + (size_t)l * NB * 3072 + 2048;
            {   pg8::Gemm g{(const bf16_t*)(ws + WS_MERGED), w3, D, 3072, D, 0, 0};
                pg8::Sched S; S.init(MP, D, 1, 0, G, (int)blockIdx.x);
                pg8::EpiOut E{l == 0 ? P.in[I_XP] : X1, l == 0 ? P.in[I_XS] : X1 + (size_t)MP * D, l == 0 ? (float*)(ws + WS_X1) : P.out + O_Y, modg};
                pg8::gemm_phase<pg8::EpiOut>(lds, g, S, E); }
            {   pg8::Gemm g{(const bf16_t*)(ws + WS_PART), w3, 3072, 3072, D, 2048, 2048};
                pg8::Sched S; S.init(MS, D, 1, 4, G, (int)((blockIdx.x + 64) % G));
                pg8::EpiOutPart E{(float*)(ws + WS_PO), modg};
                pg8::gemm_phase<pg8::EpiOutPart>(lds, g, S, E); }
        }
        }
        SEAM(ph);
    }
    if (RUN(13)) phase_final(P, G);
#undef RUN
#undef SEAM
}

extern "C" void kernel_launch(void* const* d_in, const int* in_sizes, int n_in, void* d_out, int out_size, void* d_ws, size_t ws_size, hipStream_t stream) {
    static int grid = 0;
    if (grid == 0) {
        if (n_in != 25 || (size_t)out_size != O_END || ws_size < WS_END) { fprintf(stderr, "kernel_launch: unexpected sizes n_in %d out %d ws %zu (need %zu)\n", n_in, out_size, ws_size, (size_t)WS_END); grid = -1; return; }
        int dev = 0, cus = 0, per_cu = 0;
        hipGetDevice(&dev);
        hipDeviceGetAttribute(&cus, hipDeviceAttributeMultiprocessorCount, dev);
        if (hipFuncSetAttribute((const void*)fwd_kernel, hipFuncAttributeMaxDynamicSharedMemorySize, LDS_BYTES) != hipSuccess) { fprintf(stderr, "kernel_launch: hipFuncSetAttribute failed\n"); grid = -1; return; }
        if (hipOccupancyMaxActiveBlocksPerMultiprocessor(&per_cu, (const void*)fwd_kernel, 512, LDS_BYTES) != hipSuccess || per_cu < 1) { fprintf(stderr, "kernel_launch: occupancy query says %d\n", per_cu); per_cu = 1; }
        (void)hipGetLastError();
        grid = cus * 1;
        fprintf(stderr, "kernel_launch: cus %d per_cu %d grid %d\n", cus, per_cu, grid);
    }
    if (grid < 0) return;
    if (hipMemsetAsync(d_ws, 0, 65536, stream) != hipSuccess) { fprintf(stderr, "kernel_launch: memset failed\n"); return; }
    Params p{};
    for (int i = 0; i < 25; ++i) p.in[i] = (const float*)d_in[i];
    p.out = (float*)d_out; p.ws = (unsigned char*)d_ws; p.ph_lo = 0; p.ph_hi = 14;
    void* args[] = {&p};
    hipError_t e = hipLaunchCooperativeKernel((const void*)fwd_kernel, dim3(grid), dim3(512), args, LDS_BYTES, stream);
    if (e != hipSuccess) fprintf(stderr, "kernel_launch: cooperative launch failed: %s (grid %d)\n", hipGetErrorString(e), grid);
}
```

```cpp
#include <hip/hip_runtime.h>
#include <hip/hip_cooperative_groups.h>
#include <cstdio>
#include <cstdint>
namespace cg = cooperative_groups;

#define DI __device__ __forceinline__
#define LAS __attribute__((address_space(3)))
#define GAS __attribute__((address_space(1)))
typedef unsigned short bf16_t;
typedef short bf16x8 __attribute__((ext_vector_type(8)));
typedef short s16x4 __attribute__((ext_vector_type(4)));
typedef float f32x4 __attribute__((ext_vector_type(4)));
typedef float f32x2 __attribute__((ext_vector_type(2)));
typedef float f32x16 __attribute__((ext_vector_type(16)));
typedef unsigned u32x4 __attribute__((ext_vector_type(4)));
typedef unsigned u32x2 __attribute__((ext_vector_type(2)));
typedef __bf16 bf16x2_t __attribute__((ext_vector_type(2)));
typedef LAS unsigned char* ldsp;

constexpr int D = 1024, PB = 8, PT = 2048, SB = 128, ST = 8;
constexpr int MP = PB * PT, MS = SB * ST, M = MP + MS, NB = PB + SB;
constexpr int NIN = 13320, NPROJ = 13312;
constexpr int C_MG = 0, C_U = 3072, C_VA = 4096, C_ZA = 5120, C_Q = 6144, C_K = 7168, C_V = 8192, C_OB = 9216, C_ZB = 10240, C_P = 11264, C_ZC = 12288;
constexpr int NCH = 16;
constexpr float EPS = 1e-6f;

constexpr size_t MiB = 1u << 20;
constexpr size_t WS_WIN = 1 * MiB;
constexpr size_t WS_WBR = WS_WIN + 52 * MiB;
constexpr size_t WS_WOUT = WS_WBR + 12 * MiB;
constexpr size_t WS_WPOOL = WS_WOUT + 4 * MiB;
constexpr size_t WS_WIF = WS_WPOOL + 1 * MiB;
constexpr size_t WS_MOD = WS_WIF + 1 * MiB;
constexpr size_t WS_H = WS_MOD + 4 * MiB;
constexpr size_t WS_GIF = WS_H + 34 * MiB;
constexpr size_t WS_LNS = WS_GIF + 1 * MiB;
constexpr size_t WS_POOLED = WS_LNS + 1 * MiB;
constexpr size_t WS_Y = WS_POOLED + 34 * MiB;
constexpr size_t WS_MERGED = WS_Y + 102 * MiB;
constexpr size_t WS_X1 = WS_MERGED + 34 * MiB;
constexpr size_t WS_CST = WS_X1 + 68 * MiB;
constexpr size_t WS_NST = WS_CST + 64 * MiB;
constexpr size_t WS_TOK = WS_NST + 1 * MiB;
constexpr size_t WS_PROJ = WS_TOK + 1 * MiB;
constexpr size_t WS_PART = WS_PROJ + 442 * MiB;
constexpr size_t WS_WOUT3 = WS_PART + 6 * MiB;
constexpr size_t WS_PO = WS_WOUT3 + 12 * MiB;
constexpr size_t WS_END = WS_PO + 12 * MiB;
static_assert((size_t)M * NPROJ * 2 <= 442 * MiB, "proj");
static_assert((size_t)M * D * 2 <= 34 * MiB, "act");

constexpr size_t O_Y = 0;
constexpr size_t O_CP = (size_t)M * D;
constexpr size_t O_NP = O_CP + 2ull * PB * 4 * 65536;
constexpr size_t O_MP = O_NP + 2ull * PB * 4 * 256;
constexpr size_t O_PP = O_MP + 2ull * PB * 4;
constexpr size_t O_CS = O_PP + 2ull * PB * 15 * 1024;
constexpr size_t O_NS = O_CS + 2ull * SB * 4 * 65536;
constexpr size_t O_MS = O_NS + 2ull * SB * 4 * 256;
constexpr size_t O_PS = O_MS + 2ull * SB * 4;
constexpr size_t O_VS = O_PS + 2ull * SB * 15 * 1024;
constexpr size_t O_END = O_VS + 2ull * SB * 8 * 1024;

constexpr int LDS_BYTES = 155648;

DI float bf_lo(unsigned w) { return __uint_as_float(w << 16); }
DI float bf_hi(unsigned w) { return __uint_as_float(w & 0xffff0000u); }
DI float bf2f(bf16_t h) { return __uint_as_float(((unsigned)h) << 16); }
DI unsigned pk2(float lo, float hi) { f32x2 v = {lo, hi}; bf16x2_t b = __builtin_convertvector(v, bf16x2_t); return __builtin_bit_cast(unsigned, b); }
DI bf16_t f2bf(float f) { return (bf16_t)(pk2(f, 0.f) & 0xffffu); }
DI float sigm(float t) { return __builtin_amdgcn_rcpf(1.f + __expf(-t)); }
template <int CTRL, int ROWMASK> DI float dpp_f(float v) { return __builtin_bit_cast(float, __builtin_amdgcn_update_dpp(0, __builtin_bit_cast(int, v), CTRL, ROWMASK, 0xF, false)); }
DI float wave_sum(float v) {
    v += dpp_f<0xB1, 0xF>(v);
    v += dpp_f<0x4E, 0xF>(v);
    v += dpp_f<0x141, 0xF>(v);
    v += dpp_f<0x140, 0xF>(v);
    v += dpp_f<0x142, 0xA>(v);
    v += dpp_f<0x143, 0xC>(v);
    return __builtin_bit_cast(float, __builtin_amdgcn_readlane(__builtin_bit_cast(int, v), 63));
}
DI float wave_max(float v) {
#pragma unroll
    for (int o = 1; o < 64; o <<= 1) v = fmaxf(v, __shfl_xor(v, o));
    return v;
}
DI void unpack8(u32x4 w, float* f) { f[0] = bf_lo(w.x); f[1] = bf_hi(w.x); f[2] = bf_lo(w.y); f[3] = bf_hi(w.y); f[4] = bf_lo(w.z); f[5] = bf_hi(w.z); f[6] = bf_lo(w.w); f[7] = bf_hi(w.w); }
DI int crow(int reg, int h) { return (reg & 3) + 8 * (reg >> 2) + 4 * h; }
DI int mod_row(int row) { return row < MP ? (row >> 11) : PB + ((row - MP) >> 3); }

#define MFMA32(a, b, c) __builtin_amdgcn_mfma_f32_32x32x16_bf16((a), (b), (c), 0, 0, 0)
typedef short v4i16_t __attribute__((ext_vector_type(4)));
DI s16x4 tr4(const LAS unsigned char* p) { return __builtin_bit_cast(s16x4, __builtin_amdgcn_ds_read_tr16_b64_v4i16((LAS v4i16_t*)p)); }
DI bf16x8 frag_row(const LAS unsigned char* base, int stride, int r0, int k0, int lane) {
    return *(const LAS bf16x8*)(base + (r0 + (lane & 31)) * stride + (k0 + 8 * (lane >> 5)) * 2);
}
DI bf16x8 frag_tr(const LAS unsigned char* base, int stride, int k0, int c0, int lane) {
    const int g = lane >> 4, i = lane & 15, q = i >> 2, p = i & 3, h = g >> 1;
    const LAS unsigned char* a = base + (k0 + 8 * h + q) * stride + (c0 + 16 * (g & 1) + 4 * p) * 2;
    const s16x4 lo = tr4(a), hi = tr4(a + 4 * stride);
    return __builtin_shufflevector(lo, hi, 0, 1, 2, 3, 4, 5, 6, 7);
}
DI bf16x8 frag_tr_perm(const LAS unsigned char* base, int stride, int k0, int c0, int lane) {
    const int g = lane >> 4, i = lane & 15, q = i >> 2, p = i & 3, h = g >> 1;
    const LAS unsigned char* a = base + (k0 + 4 * h + q) * stride + (c0 + 16 * (g & 1) + 4 * p) * 2;
    const s16x4 lo = tr4(a), hi = tr4(a + 8 * stride);
    return __builtin_shufflevector(lo, hi, 0, 1, 2, 3, 4, 5, 6, 7);
}

namespace pg8 {
constexpr int BM = 256, BK = 64, HALF = 128, HTB = HALF * BK * 2, STAGE_BYTES = 8 * HTB, NXCD = 8, WGM = 8;
__host__ __device__ __forceinline__ int lds_byte(int r, int c) { const int st = (r >> 4) * 2 + (c >> 5), rr = r & 15, cc = c & 31, ob = rr * 64 + cc * 2; return st * 1024 + (ob ^ (((ob >> 9) & 1) << 5)); }
__host__ __device__ __forceinline__ void stage_rc(int b, int& R, int& C) { const int st = b / 1024, sb = b % 1024, swz = sb ^ (((sb >> 9) & 1) << 5); R = (st >> 1) * 16 + swz / 64; C = (st & 1) * 32 + (swz % 64) / 2; }
__host__ __device__ __forceinline__ int perm32(int rho) { const int n = rho >> 4, i = rho & 15; return 8 * (i >> 2) + 4 * n + (i & 3); }

struct Unit { int pm, pn, z; };
struct Gemm { const bf16_t* A; const bf16_t* Bt; int lda, ldb, K; size_t zA, zB; };

struct Sched {
    int nM, nN, nz, zmode, nwg, G, c;
    __device__ void init(int Mr, int Nc, int nz_, int zmode_, int G_, int c_) { nM = Mr / BM; nN = Nc / BM; nz = nz_; zmode = zmode_; nwg = nM * nN; G = G_; c = c_; }
    __device__ bool next(int i, Unit& u) const {
        if (zmode == 3) {
            const int np = (c < nwg) ? (nwg - c + G - 1) / G : 0;
            if (i >= 3 * np) { const int sidx = c + G * (i - 3 * np); if (sidx >= 48) return false; const int tl = sidx / 3; u.pm = nM + (tl >> 2); u.pn = tl & 3; u.z = sidx - 3 * tl; return true; }
        }
        if (zmode == 4) {
            const int sidx = c + G * i; if (sidx >= 48) return false; const int tl = sidx / 3; u.pm = tl >> 2; u.pn = tl & 3; u.z = sidx - 3 * tl; return true;
        }
        int ti = i, z = 0;
        if (zmode == 1 || zmode == 3) { ti = i / nz; z = i - ti * nz; }
        const long L = (long)ti * G + c; if (L >= nwg) return false;
        int wgid = (int)L; { const int q = nwg / NXCD, r = nwg % NXCD, xcd = wgid % NXCD, off = wgid / NXCD; wgid = (xcd < r ? xcd * (q + 1) : r * (q + 1) + (xcd - r) * q) + off; }
        const int nig = WGM * nN, gid = wgid / nig, fm = gid * WGM, gsz = (nM - fm) < WGM ? (nM - fm) : WGM;
        u.pm = fm + ((wgid % nig) % gsz); u.pn = (wgid % nig) / gsz; u.z = z;
        if (zmode == 2) { u.z = u.pn; u.pn = 0; }
        return true;
    }
};

template <class Epi>
__device__ __forceinline__ void gemm_phase(ldsp lds, const Gemm g, const Sched& S, const Epi& E) {
    int tid_ = threadIdx.x; asm volatile("" : "+v"(tid_));
    const int tid = tid_, wid = __builtin_amdgcn_readfirstlane(tid >> 6), lane = tid & 63, wr = wid >> 2, wc = wid & 3, fr = lane & 15, fq = lane >> 4;
    const int K = g.K, nt = K / BK;
    unsigned voffA[2], voffB[2];
#pragma unroll
    for (int i = 0; i < 2; ++i) { int R, C; stage_rc(tid * 16 + i * 8192, R, C); const int Rb = Epi::PERM ? ((R & ~31) + perm32(R & 31)) : R;
        voffA[i] = (unsigned)(R * g.lda + C) * 2u; voffB[i] = (unsigned)(Rb * g.ldb + C) * 2u; }
    const size_t kstep = (size_t)(BK * 2);
    const size_t hsA = (size_t)HALF * g.lda * 2, hsB = (size_t)HALF * g.ldb * 2;
    const size_t tsA = 2 * hsA, tsB = 2 * hsB;
    const unsigned ldsw = (unsigned)wid * 1024u;
    const int aoff = lds_byte(wr * 64 + fr, fq * 8), boff = lds_byte(wc * 32 + fr, fq * 8);
#define PG8_SA(b, h) (((b) * 2 + (h)) * HTB)
#define PG8_SB(b, h) ((4 + (b) * 2 + (h)) * HTB)
#define PG8_STAGE(bufoff, gbase, voff) do { _Pragma("unroll") for (int _i = 0; _i < 2; ++_i) \
        __builtin_amdgcn_global_load_lds((const unsigned*)((const char*)(gbase) + (voff)[_i]), (LAS unsigned*)(lds + (bufoff) + ldsw + _i * 8192), 16, 0, 0); } while (0)
#define PG8_LDA(dst, b, h) do { _Pragma("unroll") for (int m = 0; m < 4; ++m) _Pragma("unroll") for (int k = 0; k < 2; ++k) dst[m][k] = *(const LAS bf16x8*)(lds + PG8_SA(b, h) + aoff + m * 2048 + k * 1024); } while (0)
#define PG8_LDB(dst, b, h) do { _Pragma("unroll") for (int n = 0; n < 2; ++n) _Pragma("unroll") for (int k = 0; k < 2; ++k) dst[n][k] = *(const LAS bf16x8*)(lds + PG8_SB(b, h) + boff + n * 2048 + k * 1024); } while (0)
#define PG8_MMA(ai, bj, At, Bt) do { __builtin_amdgcn_s_setprio(1); _Pragma("unroll") for (int m = 0; m < 4; ++m) _Pragma("unroll") for (int n = 0; n < 2; ++n) _Pragma("unroll") for (int k = 0; k < 2; ++k) \
        acc[ai][bj][m][n] = __builtin_amdgcn_mfma_f32_16x16x32_bf16(Bt[n][k], At[m][k], acc[ai][bj][m][n], 0, 0, 0); __builtin_amdgcn_s_setprio(0); } while (0)
#define PG8_WAIT_V(n) asm volatile("s_waitcnt vmcnt(" #n ")" ::: "memory")
#define PG8_WAIT_L(n) asm volatile("s_waitcnt lgkmcnt(" #n ")" ::: "memory")
#define PG8_BAR __builtin_amdgcn_s_barrier()
#define PG8_SCHED __builtin_amdgcn_sched_barrier(0)
    Unit cur, nxt; int ui = 0;
    if (!S.next(0, cur)) return;
    f32x4 acc[2][2][4][2];
#pragma unroll
    for (int a = 0; a < 2; ++a)
#pragma unroll
        for (int b = 0; b < 2; ++b)
#pragma unroll
            for (int m = 0; m < 4; ++m)
#pragma unroll
                for (int n = 0; n < 2; ++n) acc[a][b][m][n] = (f32x4){0.f, 0.f, 0.f, 0.f};
    bf16x8 At[4][2], B0[2][2], B1[2][2];
    const char* cA = (const char*)g.A + (size_t)cur.pm * tsA + (size_t)cur.z * g.zA; const char* cB = (const char*)g.Bt + (size_t)cur.pn * tsB + (size_t)cur.z * g.zB;
    PG8_STAGE(PG8_SB(0, 0), cB, voffB); PG8_STAGE(PG8_SB(0, 1), cB + hsB, voffB); PG8_STAGE(PG8_SA(0, 0), cA, voffA); PG8_STAGE(PG8_SA(0, 1), cA + hsA, voffA);
    if (wr == 1) PG8_BAR;
    PG8_WAIT_V(2); PG8_BAR;
    PG8_STAGE(PG8_SB(1, 0), cB + kstep, voffB); PG8_STAGE(PG8_SA(1, 0), cA + kstep, voffA); PG8_STAGE(PG8_SB(1, 1), cB + hsB + kstep, voffB);
    PG8_WAIT_V(6); PG8_BAR;
    for (;;) {
        const bool has_next = S.next(ui + 1, nxt);
        const char* nA = has_next ? (const char*)g.A + (size_t)nxt.pm * tsA + (size_t)nxt.z * g.zA : cA; const char* nB = has_next ? (const char*)g.Bt + (size_t)nxt.pn * tsB + (size_t)nxt.z * g.zB : cB;
        for (int t = 0; t < nt; t += 2) {
            const bool last = (t == nt - 2);
            const char* a1 = cA + (size_t)(t + 1) * kstep;
            const char* a2 = last ? nA : cA + (size_t)(t + 2) * kstep; const char* b2 = last ? nB : cB + (size_t)(t + 2) * kstep;
            const char* a3 = a2 + kstep; const char* b3 = b2 + kstep;
            PG8_LDB(B0, 0, 0); PG8_LDB(B1, 0, 1); PG8_SCHED; PG8_LDA(At, 0, 0); PG8_STAGE(PG8_SA(1, 1), a1 + hsA, voffA);
            PG8_WAIT_V(8); PG8_WAIT_L(0); PG8_BAR; PG8_MMA(0, 0, At, B0); PG8_MMA(0, 1, At, B1); PG8_BAR; PG8_SCHED;
            PG8_LDA(At, 0, 1); PG8_STAGE(PG8_SB(0, 0), b2, voffB); PG8_STAGE(PG8_SB(0, 1), b2 + hsB, voffB); PG8_STAGE(PG8_SA(0, 0), a2, voffA);
            PG8_WAIT_V(8); PG8_WAIT_L(0); PG8_BAR; PG8_MMA(1, 0, At, B0); PG8_MMA(1, 1, At, B1); PG8_BAR; PG8_SCHED;
            PG8_LDB(B0, 1, 0); PG8_LDB(B1, 1, 1); PG8_SCHED; PG8_LDA(At, 1, 0); PG8_STAGE(PG8_SA(0, 1), a2 + hsA, voffA);
            PG8_WAIT_V(8); PG8_WAIT_L(0); PG8_BAR; PG8_MMA(0, 0, At, B0); PG8_MMA(0, 1, At, B1); PG8_BAR; PG8_SCHED;
            PG8_LDA(At, 1, 1); PG8_STAGE(PG8_SB(1, 0), b3, voffB); PG8_STAGE(PG8_SB(1, 1), b3 + hsB, voffB); PG8_STAGE(PG8_SA(1, 0), a3, voffA);
            PG8_WAIT_V(8); PG8_WAIT_L(0); PG8_BAR; PG8_MMA(1, 0, At, B0); PG8_MMA(1, 1, At, B1); PG8_BAR; PG8_SCHED;
        }
        if (wr == 0) PG8_BAR;
        { int ln2 = __builtin_amdgcn_mbcnt_hi(~0u, __builtin_amdgcn_mbcnt_lo(~0u, 0u)); asm volatile("" : "+v"(ln2)); E(acc, cur, wr, wc, ln2 & 15, ln2 >> 4); }
        if (!has_next) break;
        if (!E.keep(cur)) {
#pragma unroll
        for (int a = 0; a < 2; ++a)
#pragma unroll
            for (int b = 0; b < 2; ++b)
#pragma unroll
                for (int m = 0; m < 4; ++m)
#pragma unroll
                    for (int n = 0; n < 2; ++n) acc[a][b][m][n] = (f32x4){0.f, 0.f, 0.f, 0.f};
        }
        cur = nxt; cA = nA; cB = nB; ++ui;
        if (wr == 1) PG8_BAR;
    }
    PG8_WAIT_V(0);
    PG8_BAR;
#undef PG8_SA
#undef PG8_SB
#undef PG8_STAGE
#undef PG8_LDA
#undef PG8_LDB
#undef PG8_MMA
#undef PG8_WAIT_V
#undef PG8_WAIT_L
#undef PG8_BAR
#undef PG8_SCHED
}

template <int MODE> DI float act(float x) {
    if (MODE == 0) return x;
    if (MODE == 4) return x * 0.0625f;
    const float t = (MODE == 3) ? 1.5957691216f * x * (1.f + 0.044715f * x * x) : x;
    const float sg = sigm(t);
    return MODE == 1 ? sg : x * sg;
}
struct EpiProj {
    static constexpr bool PERM = true;
    bf16_t* O;
    DI bool keep(const Unit&) const { return false; }
    template <int MODE> DI void run(f32x4 (&acc)[2][2][4][2], const Unit& u, int wr, int wc, int fr, int fq) const {
        const int row0 = u.pm * BM + wr * 64 + fr, col0 = u.pn * BM + wc * 32 + 8 * fq;
#pragma unroll
        for (int ai = 0; ai < 2; ++ai)
#pragma unroll
            for (int m = 0; m < 4; ++m) { bf16_t* rowp = O + (size_t)(row0 + ai * HALF + m * 16) * NPROJ + col0;
#pragma unroll
                for (int bj = 0; bj < 2; ++bj) { const f32x4 v0 = acc[ai][bj][m][0], v1 = acc[ai][bj][m][1]; u32x4 w;
                    w.x = pk2(act<MODE>(v0[0]), act<MODE>(v0[1])); w.y = pk2(act<MODE>(v0[2]), act<MODE>(v0[3]));
                    w.z = pk2(act<MODE>(v1[0]), act<MODE>(v1[1])); w.w = pk2(act<MODE>(v1[2]), act<MODE>(v1[3]));
                    *(GAS u32x4*)(rowp + bj * HALF) = w; } }
    }
    DI void operator()(f32x4 (&acc)[2][2][4][2], const Unit& u, int wr, int wc, int fr, int fq) const {
        const int seg = u.pn >> 2;
        if (seg <= 2 || seg == 9) run<1>(acc, u, wr, wc, fr, fq);
        else if (seg == 3 || seg == 4) run<3>(acc, u, wr, wc, fr, fq);
        else if (seg == 5 || seg == 10 || seg == 12) run<2>(acc, u, wr, wc, fr, fq);
        else if (seg == 7) run<4>(acc, u, wr, wc, fr, fq);
        else run<0>(acc, u, wr, wc, fr, fq);
    }
};
struct EpiPool {
    static constexpr bool PERM = true;
    bf16_t* O; const bf16_t* proj; const float* pscale;
    DI bool keep(const Unit&) const { return false; }
    DI void operator()(f32x4 (&acc)[2][2][4][2], const Unit& u, int wr, int wc, int fr, int fq) const {
        const int row0 = u.pm * BM + wr * 64 + fr, col0 = u.z * 256 + wc * 32 + 8 * fq;
        f32x4 sc[2][2];
#pragma unroll
        for (int bj = 0; bj < 2; ++bj) { sc[bj][0] = *(const GAS f32x4*)(pscale + col0 + bj * HALF); sc[bj][1] = *(const GAS f32x4*)(pscale + col0 + bj * HALF + 4); }
#pragma unroll
        for (int ai = 0; ai < 2; ++ai)
#pragma unroll
            for (int m = 0; m < 4; ++m) { const size_t row = (size_t)(row0 + ai * HALF + m * 16);
#pragma unroll
                for (int bj = 0; bj < 2; ++bj) { const int col = col0 + bj * HALF;
                    const u32x4 zw = *(const GAS u32x4*)(proj + row * NPROJ + C_ZC + col); float z[8]; unpack8(zw, z);
                    const f32x4 v0 = acc[ai][bj][m][0], v1 = acc[ai][bj][m][1], s0 = sc[bj][0], s1 = sc[bj][1]; u32x4 w;
                    w.x = pk2(v0[0] * s0[0] * z[0], v0[1] * s0[1] * z[1]); w.y = pk2(v0[2] * s0[2] * z[2], v0[3] * s0[3] * z[3]);
                    w.z = pk2(v1[0] * s1[0] * z[4], v1[1] * s1[1] * z[5]); w.w = pk2(v1[2] * s1[2] * z[6], v1[3] * s1[3] * z[7]);
                    *(GAS u32x4*)(O + row * D + col) = w; }
                asm volatile("" ::: "memory"); }
    }
};
struct EpiMerge {
    static constexpr bool PERM = true;
    bf16_t* O; bf16_t* part; const bf16_t* proj;
    DI bool keep(const Unit& u) const { return u.pm < MP / BM && u.z < 2; }
    DI void operator()(f32x4 (&acc)[2][2][4][2], const Unit& u, int wr, int wc, int fr, int fq) const {
        const int row0 = u.pm * BM + wr * 64 + fr, col0 = u.pn * BM + wc * 32 + 8 * fq;
        const bool samp = u.pm >= MP / BM;
#pragma unroll
        for (int ai = 0; ai < 2; ++ai)
#pragma unroll
            for (int m = 0; m < 4; ++m) { const size_t row = (size_t)(row0 + ai * HALF + m * 16);
#pragma unroll
                for (int bj = 0; bj < 2; ++bj) { const int col = col0 + bj * HALF;
                    const u32x4 gw = *(const GAS u32x4*)(proj + row * NPROJ + C_MG + u.z * 1024 + col); float gt[8]; unpack8(gw, gt);
                    f32x4& v0 = acc[ai][bj][m][0]; f32x4& v1 = acc[ai][bj][m][1];
                    if (samp || u.z == 2) {
                        u32x4 w;
                        w.x = pk2(gt[0] * v0[0], gt[1] * v0[1]); w.y = pk2(gt[2] * v0[2], gt[3] * v0[3]);
                        w.z = pk2(gt[4] * v1[0], gt[5] * v1[1]); w.w = pk2(gt[6] * v1[2], gt[7] * v1[3]);
                        if (samp) *(GAS u32x4*)(part + (row - MP) * 3072 + u.z * 1024 + col) = w; else *(GAS u32x4*)(O + row * D + col) = w;
                    } else {
                        const u32x4 nw = *(const GAS u32x4*)(proj + row * NPROJ + C_MG + (u.z + 1) * 1024 + col); float gn[8]; unpack8(nw, gn);
#pragma unroll
                        for (int e = 0; e < 8; ++e) gt[e] *= __builtin_amdgcn_rcpf(fmaxf(gn[e], 1e-30f));
                        v0[0] *= gt[0]; v0[1] *= gt[1]; v0[2] *= gt[2]; v0[3] *= gt[3]; v1[0] *= gt[4]; v1[1] *= gt[5]; v1[2] *= gt[6]; v1[3] *= gt[7];
                    } }
                if (m & 1) asm volatile("" ::: "memory"); }
    }
};
struct EpiOut {
    static constexpr bool PERM = false;
    const float* xp; const float* xs; float* out; const float* modg;
    DI bool keep(const Unit&) const { return false; }
    DI void operator()(f32x4 (&acc)[2][2][4][2], const Unit& u, int wr, int wc, int fr, int fq) const {
        const int row0 = u.pm * BM + wr * 64 + fr, col0 = u.pn * BM + wc * 32 + 4 * fq;
#pragma unroll
        for (int ai = 0; ai < 2; ++ai)
#pragma unroll
            for (int m = 0; m < 4; ++m) { const int row = row0 + ai * HALF + m * 16;
                const float* xr = row < MP ? xp + (size_t)row * D : xs + (size_t)(row - MP) * D;
                const float* gr = modg + (size_t)mod_row(row) * 3072;
#pragma unroll
                for (int bj = 0; bj < 2; ++bj)
#pragma unroll
                    for (int n = 0; n < 2; ++n) { const int col = col0 + bj * HALF + n * 16;
                        const f32x4 xv = *(const GAS f32x4*)(xr + col), gv = *(const GAS f32x4*)(gr + col);
                        *(GAS f32x4*)(out + (size_t)row * D + col) = xv + gv * acc[ai][bj][m][n]; } }
    }
};
struct EpiOutPart {
    static constexpr bool PERM = false;
    float* po; const float* modg;
    DI bool keep(const Unit&) const { return false; }
    DI void operator()(f32x4 (&acc)[2][2][4][2], const Unit& u, int wr, int wc, int fr, int fq) const {
        const int row0 = u.pm * BM + wr * 64 + fr, col0 = u.pn * BM + wc * 32 + 4 * fq;
        float* ob = po + (size_t)u.z * MS * D;
#pragma unroll
        for (int ai = 0; ai < 2; ++ai)
#pragma unroll
            for (int m = 0; m < 4; ++m) { const int row = row0 + ai * HALF + m * 16;
                const float* gr = modg + (size_t)(PB + (row >> 3)) * 3072;
#pragma unroll
                for (int bj = 0; bj < 2; ++bj)
#pragma unroll
                    for (int n = 0; n < 2; ++n) { const int col = col0 + bj * HALF + n * 16;
                        const f32x4 gv = *(const GAS f32x4*)(gr + col);
                        *(GAS f32x4*)(ob + (size_t)row * D + col) = gv * acc[ai][bj][m][n]; } }
    }
};
}

struct Params { const float* in[25]; float* out; unsigned char* ws; int ph_lo, ph_hi; };
enum { I_XP = 0, I_XS, I_CP, I_CS, I_SC, I_SN, I_SM, I_SP, I_WMOD, I_BMOD, I_NORMG, I_WIN, I_BIF, I_LNG, I_LNB, I_WSGU, I_BSGU, I_MNG, I_WPOOL, I_PSCALE, I_WBRA, I_WBRB, I_WBRC, I_WOUT, I_FNG };

DI void transpose_item(const float* W, int ldw, int K, bf16_t* WT, int src_col0, int dst_row0, int k0, LAS float* scr, int lane) {
    float tv[32];
#pragma unroll
    for (int i = 0; i < 32; ++i) tv[i] = W[(size_t)(k0 + 2 * i + (lane >> 5)) * ldw + src_col0 + (lane & 31)];
#pragma unroll
    for (int i = 0; i < 32; ++i) scr[(2 * i + (lane >> 5)) * 33 + (lane & 31)] = tv[i];
    asm volatile("s_waitcnt lgkmcnt(0)" ::: "memory");
    const int c = lane & 7;
#pragma unroll
    for (int j = 0; j < 4; ++j) { const int n = (lane >> 3) + 8 * j; const LAS float* s = scr + (8 * c) * 33 + n;
        u32x4 o; o.x = pk2(s[0 * 33], s[1 * 33]); o.y = pk2(s[2 * 33], s[3 * 33]); o.z = pk2(s[4 * 33], s[5 * 33]); o.w = pk2(s[6 * 33], s[7 * 33]);
        *(GAS u32x4*)(WT + (size_t)(dst_row0 + n) * K + k0 + 8 * c) = o; }
    asm volatile("s_waitcnt lgkmcnt(0)" ::: "memory");
}

DI void transpose_item3(const float* W, bf16_t* WT, int n0, int k0, LAS float* scr, int lane) {
    float tv[32];
#pragma unroll
    for (int i = 0; i < 32; ++i) tv[i] = W[(size_t)(k0 + 2 * i + (lane >> 5)) * D + n0 + (lane & 31)];
#pragma unroll
    for (int i = 0; i < 32; ++i) scr[(2 * i + (lane >> 5)) * 33 + (lane & 31)] = tv[i];
    asm volatile("s_waitcnt lgkmcnt(0)" ::: "memory");
    const int c = lane & 7;
#pragma unroll
    for (int j = 0; j < 4; ++j) { const int n = (lane >> 3) + 8 * j; const LAS float* sp = scr + (8 * c) * 33 + n;
        u32x4 o; o.x = pk2(sp[0 * 33], sp[1 * 33]); o.y = pk2(sp[2 * 33], sp[3 * 33]); o.z = pk2(sp[4 * 33], sp[5 * 33]); o.w = pk2(sp[6 * 33], sp[7 * 33]);
        bf16_t* dst = WT + (size_t)(n0 + n) * 3072 + k0 + 8 * c;
        *(u32x4*)dst = o; *(GAS u32x4*)(dst + 1024) = o; *(GAS u32x4*)(dst + 2048) = o; }
    asm volatile("s_waitcnt lgkmcnt(0)" ::: "memory");
}

DI void phase_prologue(const Params& P, ldsp lds, int G) {
    int tid_ = threadIdx.x; asm volatile("" : "+v"(tid_));
    const int tid = tid_, lane = tid & 63, wave = __builtin_amdgcn_readfirstlane(tid >> 6);
    unsigned char* ws = P.ws; asm volatile("" : "+s"(ws));
    LAS float* scr = (LAS float*)(lds + wave * 8448);
    const int gw = blockIdx.x * 8 + wave, NGW = G * 8;
    constexpr int I_IN = 16 * 416, I_BR = 16 * 32;
    constexpr int NIT = 2 * I_IN + 6 * I_BR + 2 * I_BR;
    for (int it = gw; it < NIT; it += NGW) {
        int r = it;
        if (r < 2 * I_IN) { const int l = r / I_IN; r -= l * I_IN; const int kb = r / 416, nb = r % 416; const int n0 = nb * 32; const int sc = n0 + (n0 >= 11264 ? 8 : 0);
            transpose_item(P.in[I_WIN] + (size_t)l * D * NIN, NIN, D, (bf16_t*)(ws + WS_WIN) + (size_t)l * NPROJ * D, sc, n0, kb * 64, scr, lane); continue; }
        r -= 2 * I_IN;
        if (r < 6 * I_BR) { const int lb = r / I_BR; r -= lb * I_BR; const int l = lb / 3, br = lb % 3; const int kb = r / 32, nb = r % 32;
            const float* W = P.in[I_WBRA + br] + (size_t)l * D * D;
            transpose_item(W, D, D, (bf16_t*)(ws + WS_WBR) + (size_t)lb * D * D, nb * 32, nb * 32, kb * 64, scr, lane); continue; }
        r -= 6 * I_BR;
        { const int l = r / I_BR; r -= l * I_BR; const int kb = r / 32, nb = r % 32;
            transpose_item3(P.in[I_WOUT] + (size_t)l * D * D, (bf16_t*)(ws + WS_WOUT3) + (size_t)l * D * 3072, nb * 32, kb * 64, scr, lane); }
    }
    for (int e = blockIdx.x * 512 + tid; e < 2 * 8 * 1024; e += G * 512) { const int l = e >> 13, j = (e >> 10) & 7, k = e & 1023;
        ((float*)(ws + WS_WIF))[e] = P.in[I_WIN][(size_t)l * D * NIN + (size_t)k * NIN + 11264 + j]; }
    __syncthreads();
    LAS float* sc = (LAS float*)lds;
    LAS float* RED = (LAS float*)(lds + 82944);
    for (int e = tid; e < 160 * 129; e += 512) sc[e] = 0.f;
    const int h5 = lane >> 5, r5 = lane & 31;
    for (int it = blockIdx.x; it < 192; it += G) {
        const int l = it / 96, n0 = (it % 96) * 32;
        const float* Wm = P.in[I_WMOD] + (size_t)l * D * 3072 + n0 + r5;
        f32x16 acc[5];
#pragma unroll
        for (int rt = 0; rt < 5; ++rt)
#pragma unroll
            for (int r = 0; r < 16; ++r) acc[rt][r] = 0.f;
        __syncthreads();
        float bq[8];
#pragma unroll
        for (int ks = 0; ks < 8; ++ks) bq[ks] = Wm[(size_t)(wave * 16 + 2 * ks + h5) * 3072];
#pragma unroll 1
        for (int kc = 0; kc < 8; ++kc) {
            __syncthreads();
            for (int e = tid; e < NB * 128; e += 512) { const int r = e >> 7, kk = e & 127; const float cv = (r < PB) ? P.in[I_CP][r * D + kc * 128 + kk] : P.in[I_CS][(r - PB) * D + kc * 128 + kk]; sc[r * 129 + kk] = cv * sigm(cv); }
            __syncthreads();
            float bc[8];
#pragma unroll
            for (int ks = 0; ks < 8; ++ks) bc[ks] = bq[ks];
            if (kc < 7) {
#pragma unroll
                for (int ks = 0; ks < 8; ++ks) bq[ks] = Wm[(size_t)((kc + 1) * 128 + wave * 16 + 2 * ks + h5) * 3072]; }
#pragma unroll
            for (int ks = 0; ks < 8; ++ks) {
                const int kl = wave * 16 + 2 * ks + h5;
#pragma unroll
                for (int rt = 0; rt < 5; ++rt) { const float a = sc[(32 * rt + r5) * 129 + kl]; acc[rt] = __builtin_amdgcn_mfma_f32_32x32x2f32(a, bc[ks], acc[rt], 0, 0, 0); }
            }
        }
        for (int w = 0; w < 8; ++w) {
            if (wave == w) {
#pragma unroll
                for (int rt = 0; rt < 5; ++rt)
#pragma unroll
                    for (int r = 0; r < 16; ++r) { LAS float* p = RED + (32 * rt + crow(r, h5)) * 32 + r5; *p = (w == 0 ? 0.f : *p) + acc[rt][r]; } }
            __syncthreads();
        }
        for (int e = tid; e < NB * 32; e += 512) { const int r = e >> 5, cn = e & 31; ((float*)(ws + WS_MOD))[((size_t)l * NB + r) * 3072 + n0 + cn] = RED[e] + P.in[I_BMOD][l * 3072 + n0 + cn]; }
    }
    __syncthreads();
}

DI void phase_norm(const Params& P, ldsp lds, int G, int l) {
    int tid_ = threadIdx.x; asm volatile("" : "+v"(tid_));
    const int tid = tid_, lane = tid & 63, wave = __builtin_amdgcn_readfirstlane(tid >> 6);
    unsigned char* ws = P.ws; asm volatile("" : "+s"(ws));
    LAS float* wif = (LAS float*)lds;
    for (int e = tid; e < 8192; e += 512) wif[e] = ((const float*)(ws + WS_WIF))[l * 8192 + e];
    __syncthreads();
    const float* X1 = (const float*)(ws + WS_X1);
    const float* mod = (const float*)(ws + WS_MOD) + (size_t)l * NB * 3072;
    const float* ng = P.in[I_NORMG] + l * D;
    f32x4 vn[4];
    {   const int row = blockIdx.x * 8 + wave;
        const float* xr = (row >= MP) ? P.in[I_XS] + (size_t)(row - MP) * D : (l == 0 ? P.in[I_XP] + (size_t)row * D : X1 + (size_t)row * D);
#pragma unroll
        for (int j = 0; j < 4; ++j) vn[j] = ((const GAS f32x4*)xr)[lane + 64 * j]; }
    for (int row = blockIdx.x * 8 + wave; row < M; row += G * 8) {
        f32x4 v[4]; float ss = 0.f;
#pragma unroll
        for (int j = 0; j < 4; ++j) v[j] = vn[j];
        {   const int rown = row + G * 8;
            if (rown < M) { const float* xr = (rown >= MP) ? P.in[I_XS] + (size_t)(rown - MP) * D : (l == 0 ? P.in[I_XP] + (size_t)rown * D : X1 + (size_t)rown * D);
#pragma unroll
                for (int j = 0; j < 4; ++j) vn[j] = ((const GAS f32x4*)xr)[lane + 64 * j]; } }
        if (l == 1 && row >= MP) {
            const float* po = (const float*)(ws + WS_PO) + (size_t)(row - MP) * D; float* xo = (float*)(ws + WS_X1) + (size_t)row * D;
#pragma unroll
            for (int j = 0; j < 4; ++j) { v[j] += ((const GAS f32x4*)po)[lane + 64 * j] + ((const GAS f32x4*)(po + (size_t)MS * D))[lane + 64 * j] + ((const GAS f32x4*)(po + 2 * (size_t)MS * D))[lane + 64 * j]; ((GAS f32x4*)xo)[lane + 64 * j] = v[j]; } }
#pragma unroll
        for (int j = 0; j < 4; ++j) ss += v[j][0] * v[j][0] + v[j][1] * v[j][1] + v[j][2] * v[j][2] + v[j][3] * v[j][3];
        const float rms = rsqrtf(wave_sum(ss) * (1.f / D) + EPS);
        const float* mr = mod + (size_t)mod_row(row) * 3072;
        float gd[8];
#pragma unroll
        for (int q = 0; q < 8; ++q) gd[q] = 0.f;
#pragma unroll
        for (int j = 0; j < 4; ++j) {
            const int e = 4 * (lane + 64 * j);
            const f32x4 g4 = *(const GAS f32x4*)(ng + e), sh = *(const GAS f32x4*)(mr + e), scl = *(const GAS f32x4*)(mr + 1024 + e);
            f32x4 hv = (v[j] * rms) * g4 * (scl + 1.f) + sh;
            u32x2 o; o.x = pk2(hv[0], hv[1]); o.y = pk2(hv[2], hv[3]);
            *(GAS u32x2*)((bf16_t*)(ws + WS_H) + (size_t)row * D + e) = o;
#pragma unroll
            for (int q = 0; q < 8; ++q) { const f32x4 w4 = *(const LAS f32x4*)(wif + q * 1024 + e); gd[q] += hv[0] * w4[0] + hv[1] * w4[1] + hv[2] * w4[2] + hv[3] * w4[3]; }
        }
#pragma unroll
        for (int q = 0; q < 8; ++q) gd[q] = wave_sum(gd[q]);
        if (lane < 8) { float val = gd[0];
#pragma unroll
            for (int q = 1; q < 8; ++q) val = (lane == q) ? gd[q] : val;
            ((float*)(ws + WS_GIF))[(size_t)row * 8 + lane] = val + P.in[I_BIF][l * 8 + lane]; }
    }
    __syncthreads();
}

DI float log_sigmoid(float x) { return fminf(x, 0.f) - log1pf(__expf(-fabsf(x))); }

constexpr int TS = 528;
constexpr int XS = 576;
DI void scan_item(const Params& P, ldsp lds, int l, int it) {
    int tid_ = threadIdx.x; asm volatile("" : "+v"(tid_));
    const int tid = tid_, lane = tid & 63, wave = __builtin_amdgcn_readfirstlane(tid >> 6);
    unsigned char* ws = P.ws; asm volatile("" : "+s"(ws));
    const int bh = it >> 3, sl = it & 7, b = bh >> 2, hh = bh & 3;
    const int row0 = b * PT;
    const ldsp KT = lds;
    const ldsp VT = lds + 73728;
    LAS float* GA = (LAS float*)(lds + 81920);
    LAS float* GB = GA + 2048;
    LAS float* GC = GB + 2048;
    LAS float* CH = GC + 2048;
    LAS float* WE = CH + 96;
    const float* gif = (const float*)(ws + WS_GIF);
    const bf16_t* proj = (const bf16_t*)(ws + WS_PROJ);
    __syncthreads();
#pragma unroll
    for (int cc = 0; cc < 2; ++cc) {
        const int c = 2 * wave + cc; const size_t r = (size_t)(row0 + c * 128 + 2 * lane);
        const float i0 = gif[r * 8 + hh], i1 = gif[(r + 1) * 8 + hh];
        const float f0 = log_sigmoid(gif[r * 8 + 4 + hh]), f1 = log_sigmoid(gif[(r + 1) * 8 + 4 + hh]);
        float s = f0 + f1;
#pragma unroll
        for (int o = 1; o < 64; o <<= 1) { const float t = __shfl_up(s, o); if (lane >= o) s += t; }
        const float b1 = s, b0 = s - f1, a0 = i0 - b0, a1 = i1 - b1;
        float pm = fmaxf(a0, a1);
#pragma unroll
        for (int o = 1; o < 64; o <<= 1) { const float t = __shfl_up(pm, o); if (lane >= o) pm = fmaxf(pm, t); }
        float ex = __shfl_up(pm, 1); if (lane == 0) ex = -INFINITY;
        GA[c * 128 + 2 * lane] = a0; GA[c * 128 + 2 * lane + 1] = a1;
        GB[c * 128 + 2 * lane] = b0; GB[c * 128 + 2 * lane + 1] = b1;
        GC[c * 128 + 2 * lane] = fmaxf(ex, a0); GC[c * 128 + 2 * lane + 1] = pm;
        if (lane == 63) { CH[c] = pm; CH[16 + c] = s; }
    }
    __syncthreads();
    if (tid == 0) { float m = 0.f;
        for (int c = 0; c < 16; ++c) { CH[32 + c] = m; const float Me = fmaxf(m, CH[c]); CH[49 + c] = Me; m = CH[16 + c] + Me; }
        CH[48] = m; }
    __syncthreads();
    if (sl == 0) {
        float* tok = (float*)(ws + WS_TOK);
        for (int idx = tid; idx < 2048; idx += 512) { const int c = idx >> 7; const float mc = CH[32 + c], Mt = fmaxf(mc, GC[idx]);
            tok[(size_t)bh * 2048 + idx] = GA[idx];
            tok[(size_t)(32 + bh) * 2048 + idx] = Mt;
            tok[(size_t)(64 + bh) * 2048 + idx] = __expf(mc - Mt);
            tok[(size_t)(96 + bh) * 2048 + idx] = __expf(-(GB[idx] + Mt)); }
        if (tid == 0) P.out[O_MP + (size_t)l * 32 + bh] = CH[48];
    }
    f32x16 acc;
#pragma unroll
    for (int r = 0; r < 16; ++r) acc[r] = 0.f;
    float nacc = 0.f;
    u32x4 kreg[8]; u32x4 vreg; u32x4 kreg2[8]; u32x4 vreg2;
    const int krow = tid >> 5, kcc = tid & 31, vrow = tid >> 2, vcc = tid & 3;
    {   const bf16_t* base = proj + (size_t)row0 * NPROJ;
#pragma unroll
        for (int i = 0; i < 8; ++i) kreg[i] = *(const GAS u32x4*)(base + (size_t)(krow + 16 * i) * NPROJ + C_K + hh * 256 + kcc * 8);
        vreg = *(const GAS u32x4*)(base + (size_t)vrow * NPROJ + C_V + hh * 256 + sl * 32 + vcc * 8);
        const bf16_t* base1 = base + (size_t)128 * NPROJ;
#pragma unroll
        for (int i = 0; i < 8; ++i) kreg2[i] = *(const GAS u32x4*)(base1 + (size_t)(krow + 16 * i) * NPROJ + C_K + hh * 256 + kcc * 8);
        vreg2 = *(const GAS u32x4*)(base1 + (size_t)vrow * NPROJ + C_V + hh * 256 + sl * 32 + vcc * 8); }
    const int h5 = lane >> 5;
    LAS float* NP = WE + 128;
    float dprev = 0.f;
#define SCAN_CHUNK(CI, KR, VR) do { const int c = (CI); \
        const float Me = CH[49 + c]; \
        if (tid < 32) { if (c > 0) { float s = 0.f; \
        _Pragma("unroll") \
                for (int sg = 0; sg < 16; ++sg) s += NP[sg * 32 + tid]; \
                nacc = dprev * nacc + s; } \
            ((float*)(ws + WS_NST))[(size_t)(bh * NCH + c) * 256 + 32 * sl + tid] = nacc; } \
        _Pragma("unroll") \
        for (int i = 0; i < 8; ++i) *(LAS u32x4*)(KT + (krow + 16 * i) * XS + kcc * 16) = KR[i]; \
        { const float we = __expf(GA[c * 128 + vrow] - Me); float f[8]; unpack8(VR, f); u32x4 o; \
          o.x = pk2(f[0] * we, f[1] * we); o.y = pk2(f[2] * we, f[3] * we); o.z = pk2(f[4] * we, f[5] * we); o.w = pk2(f[6] * we, f[7] * we); \
          *(LAS u32x4*)(VT + vrow * 64 + vcc * 16) = o; } \
        if (tid < 128) WE[tid] = __expf(GA[c * 128 + tid] - Me); \
        __syncthreads(); \
        if (c + 2 < NCH) { const bf16_t* base = proj + (size_t)(row0 + (c + 2) * 128) * NPROJ; \
        _Pragma("unroll") \
            for (int i = 0; i < 8; ++i) KR[i] = *(const GAS u32x4*)(base + (size_t)(krow + 16 * i) * NPROJ + C_K + hh * 256 + kcc * 8); \
            VR = *(const GAS u32x4*)(base + (size_t)vrow * NPROJ + C_V + hh * 256 + sl * 32 + vcc * 8); } \
        { GAS bf16_t* cs = (GAS bf16_t*)(ws + WS_CST) + ((size_t)(bh * NCH + c) * 256) * 256 + sl * 32 + (lane & 31); \
        _Pragma("unroll") \
          for (int r = 0; r < 16; ++r) cs[(size_t)(32 * wave + crow(r, h5)) * 256] = f2bf(acc[r]); } \
        const float decay = __expf(CH[32 + c] - Me); \
        _Pragma("unroll") \
        for (int r = 0; r < 16; ++r) acc[r] *= decay; \
        _Pragma("unroll") \
        for (int kk = 0; kk < 8; ++kk) { const bf16x8 a = frag_tr(KT, XS, 16 * kk, 32 * wave, lane), bb = frag_tr(VT, 64, 16 * kk, 0, lane); acc = MFMA32(a, bb, acc); } \
        { const int dkl = tid & 31, sg = tid >> 5; float s = 0.f; \
        _Pragma("unroll") \
          for (int j = 0; j < 8; ++j) s += WE[8 * sg + j] * bf2f(*(const LAS bf16_t*)(KT + (8 * sg + j) * XS + (32 * sl + dkl) * 2)); \
          NP[sg * 32 + dkl] = s; dprev = decay; } \
        __syncthreads(); \
    } while (0)
    for (int c2 = 0; c2 < NCH; c2 += 2) { SCAN_CHUNK(c2, kreg, vreg); SCAN_CHUNK(c2 + 1, kreg2, vreg2); }
#undef SCAN_CHUNK
    { GAS float* co = (GAS float*)P.out + O_CP + ((size_t)(l * 32 + bh) * 256) * 256 + sl * 32 + (lane & 31);
#pragma unroll
      for (int r = 0; r < 16; ++r) co[(size_t)(32 * wave + crow(r, h5)) * 256] = acc[r]; }
    if (tid < 32) { float s = 0.f;
#pragma unroll
        for (int sg = 0; sg < 16; ++sg) s += NP[sg * 32 + tid];
        P.out[O_NP + (size_t)(l * 32 + bh) * 256 + 32 * sl + tid] = dprev * nacc + s; }
}

DI void sample_mlstm_item(const Params& P, ldsp lds, int l, int it) {
    int tid_ = threadIdx.x; asm volatile("" : "+v"(tid_));
    const int tid = tid_, lane = tid & 63, wave = __builtin_amdgcn_readfirstlane(tid >> 6);
    unsigned char* ws = P.ws; asm volatile("" : "+s"(ws));
    const int b = it >> 2, hh = it & 3;
    const int row0 = MP + b * 8;
    LAS float* QS = (LAS float*)lds;
    LAS float* KS = QS + 2048;
    LAS float* KW = KS + 2048;
    LAS float* PS = KW + 2048;
    LAS float* QN = PS + 64;
    LAS float* RED = QN + 64;
    const float* gif = (const float*)(ws + WS_GIF);
    const bf16_t* proj = (const bf16_t*)(ws + WS_PROJ);
    const size_t sidx = (size_t)(l * SB + b) * 4 + hh;
    const float m0 = P.in[I_SM][sidx];
    bf16_t qraw[4], kraw[4];
#pragma unroll
    for (int i = 0; i < 4; ++i) { const int e = tid + 512 * i, t = e >> 8, dk = e & 255;
        qraw[i] = proj[(size_t)(row0 + t) * NPROJ + C_Q + hh * 256 + dk]; kraw[i] = proj[(size_t)(row0 + t) * NPROJ + C_K + hh * 256 + dk]; }
    f32x4 v[8];
#pragma unroll
    for (int s = 0; s < 8; ++s) { const u32x2 w = *(const GAS u32x2*)(proj + (size_t)(row0 + s) * NPROJ + C_V + hh * 256 + 4 * lane); v[s] = (f32x4){bf_lo(w.x), bf_hi(w.x), bf_lo(w.y), bf_hi(w.y)}; }
    float ig[8], bc[8], a[8], Mt[8];
    { float s = 0.f, cm = -INFINITY;
#pragma unroll
      for (int t = 0; t < 8; ++t) { ig[t] = gif[(size_t)(row0 + t) * 8 + hh]; s += log_sigmoid(gif[(size_t)(row0 + t) * 8 + 4 + hh]); bc[t] = s; a[t] = ig[t] - s; cm = fmaxf(cm, a[t]); Mt[t] = fmaxf(m0, cm); } }
    const float Mend = Mt[7], decay = __expf(m0 - Mend), mnew = bc[7] + Mend;
    float wexp[8];
#pragma unroll
    for (int s = 0; s < 8; ++s) wexp[s] = __expf(a[s] - Mend);
    __syncthreads();
#pragma unroll
    for (int i = 0; i < 4; ++i) { const int e = tid + 512 * i, t = e >> 8, dk = e & 255;
        const float qv = bf2f(qraw[i]), kv = bf2f(kraw[i]);
        float we = 0.f;
#pragma unroll
        for (int s = 0; s < 8; ++s) we = (t == s) ? wexp[s] : we;
        QS[dk * 8 + t] = qv; KS[dk * 8 + t] = kv; KW[dk * 8 + t] = kv * we; }
    __syncthreads();
    const float* n0 = P.in[I_SN] + sidx * 256;
    {
        const int pr = tid >> 3, t = pr >> 3, s = pr & 7, ch = tid & 7; float d = 0.f;
#pragma unroll 4
        for (int dk = 32 * ch; dk < 32 * ch + 32; ++dk) d += QS[dk * 8 + t] * KS[dk * 8 + s];
        d += __shfl_xor(d, 1); d += __shfl_xor(d, 2); d += __shfl_xor(d, 4);
        float as = 0.f, mt = 0.f;
#pragma unroll
        for (int j = 0; j < 8; ++j) { as = (s == j) ? a[j] : as; mt = (t == j) ? Mt[j] : mt; }
        const float pw = d * __expf(as - mt);
        if (ch == 0) PS[pr] = (s <= t) ? pw : 0.f; }
    if (tid < 64) { const int t = tid >> 3, ch = tid & 7; float d = 0.f;
#pragma unroll 4
        for (int dk = 32 * ch; dk < 32 * ch + 32; ++dk) d += QS[dk * 8 + t] * n0[dk];
        d += __shfl_xor(d, 1); d += __shfl_xor(d, 2); d += __shfl_xor(d, 4);
        if (ch == 0) QN[t] = d; }
    f32x4 hc[8];
#pragma unroll
    for (int t = 0; t < 8; ++t) hc[t] = (f32x4){0.f, 0.f, 0.f, 0.f};
    const float* C0 = P.in[I_SC] + sidx * 65536;
    float* Cn = P.out + O_CS + sidx * 65536;
    for (int i = 0; i < 32; i += 8) {
        f32x4 cv[8];
#pragma unroll
        for (int u = 0; u < 8; ++u) cv[u] = __builtin_nontemporal_load((const GAS f32x4*)(C0 + (size_t)(wave + 8 * (i + u)) * 256) + lane);
#pragma unroll
        for (int u = 0; u < 8; ++u) { const int dk = wave + 8 * (i + u);
            const f32x4 q0 = *(const LAS f32x4*)(QS + dk * 8), q1 = *(const LAS f32x4*)(QS + dk * 8 + 4), k0 = *(const LAS f32x4*)(KW + dk * 8), k1 = *(const LAS f32x4*)(KW + dk * 8 + 4);
            f32x4 cn = cv[u] * decay;
            cn += v[0] * k0[0]; cn += v[1] * k0[1]; cn += v[2] * k0[2]; cn += v[3] * k0[3]; cn += v[4] * k1[0]; cn += v[5] * k1[1]; cn += v[6] * k1[2]; cn += v[7] * k1[3];
            __builtin_nontemporal_store(cn, (GAS f32x4*)(Cn + (size_t)dk * 256) + lane);
            hc[0] += cv[u] * q0[0]; hc[1] += cv[u] * q0[1]; hc[2] += cv[u] * q0[2]; hc[3] += cv[u] * q0[3]; hc[4] += cv[u] * q1[0]; hc[5] += cv[u] * q1[1]; hc[6] += cv[u] * q1[2]; hc[7] += cv[u] * q1[3]; }
    }
#pragma unroll
    for (int t = 0; t < 8; ++t) *(LAS f32x4*)(RED + (wave * 8 + t) * 256 + 4 * lane) = hc[t];
    __syncthreads();
    {
        const int t = wave; f32x4 s = (f32x4){0.f, 0.f, 0.f, 0.f};
#pragma unroll
        for (int w = 0; w < 8; ++w) s += *(const LAS f32x4*)(RED + (w * 8 + t) * 256 + 4 * lane);
        float mt = 0.f, bt = 0.f;
#pragma unroll
        for (int j = 0; j < 8; ++j) { mt = (t == j) ? Mt[j] : mt; bt = (t == j) ? bc[j] : bt; }
        const float wi = __expf(m0 - mt);
        f32x4 num = s * wi; float den = wi * QN[t];
#pragma unroll
        for (int sI = 0; sI < 8; ++sI) { const float p = PS[t * 8 + sI]; num += v[sI] * p; den += p; }
        const float dd = fmaxf(fabsf(den), __expf(-(bt + mt)));
        const size_t row = (size_t)(row0 + t);
        const u32x2 ow = *(const GAS u32x2*)(proj + row * NPROJ + C_OB + hh * 256 + 4 * lane), zw = *(const GAS u32x2*)(proj + row * NPROJ + C_ZB + hh * 256 + 4 * lane);
        f32x4 hb = num * (1.f / dd) * (f32x4){bf_lo(ow.x), bf_hi(ow.x), bf_lo(ow.y), bf_hi(ow.y)};
        const float mu = wave_sum(hb[0] + hb[1] + hb[2] + hb[3]) * (1.f / 256.f);
        const f32x4 dv = hb - mu;
        const float rstd = rsqrtf(wave_sum(dv[0] * dv[0] + dv[1] * dv[1] + dv[2] * dv[2] + dv[3] * dv[3]) * (1.f / 256.f) + EPS);
        const f32x4 g4 = *(const GAS f32x4*)(P.in[I_MNG] + l * D + hh * 256 + 4 * lane);
        const f32x4 y = dv * rstd * g4 * (f32x4){bf_lo(zw.x), bf_hi(zw.x), bf_lo(zw.y), bf_hi(zw.y)};
        u32x2 o; o.x = pk2(y[0], y[1]); o.y = pk2(y[2], y[3]);
        *(GAS u32x2*)((bf16_t*)(ws + WS_Y) + ((size_t)M + row) * D + hh * 256 + 4 * lane) = o;
    }
    if (tid < 256) { float s = 0.f;
#pragma unroll
        for (int j = 0; j < 8; ++j) s += KW[tid * 8 + j];
        P.out[O_NS + sidx * 256 + tid] = decay * n0[tid] + s; }
    if (tid == 0) P.out[O_MS + sidx] = mnew;
    __syncthreads();
}

DI void lnstats_rows(const Params& P, int G) {
    int tid_ = threadIdx.x; asm volatile("" : "+v"(tid_));
    const int tid = tid_, lane = tid & 63, wave = __builtin_amdgcn_readfirstlane(tid >> 6);
    const bf16_t* proj = (const bf16_t*)(P.ws + WS_PROJ);
    for (int row0 = blockIdx.x * 8 + wave; row0 < MP; row0 += G * 8 * 4) {
        u32x4 ra[4], rb[4];
#pragma unroll
        for (int k = 0; k < 4; ++k) { const int row = row0 + k * G * 8; if (row < MP) { ra[k] = *(const GAS u32x4*)(proj + (size_t)row * NPROJ + C_VA + 8 * lane); rb[k] = *(const GAS u32x4*)(proj + (size_t)row * NPROJ + C_VA + 512 + 8 * lane); } }
#pragma unroll
        for (int k = 0; k < 4; ++k) { const int row = row0 + k * G * 8; if (row < MP) {
            float f[16]; unpack8(ra[k], f); unpack8(rb[k], f + 8);
            float sm = 0.f;
#pragma unroll
            for (int j = 0; j < 16; ++j) sm += f[j];
            const float mu = wave_sum(sm) * (1.f / D); float q = 0.f;
#pragma unroll
            for (int j = 0; j < 16; ++j) { const float d = f[j] - mu; q += d * d; }
            const float rstd = rsqrtf(wave_sum(q) * (1.f / D) + EPS);
            if (lane == 0) *(GAS f32x2*)((float*)(P.ws + WS_LNS) + (size_t)row * 2) = (f32x2){mu, rstd}; } }
    }
}

DI void pool_prompt_item(const Params& P, int l, int it) {
    int tid_ = threadIdx.x; asm volatile("" : "+v"(tid_));
    const int tid = tid_;
    const bf16_t* proj = (const bf16_t*)(P.ws + WS_PROJ);
    const int cc = tid & 127, tq = tid >> 7, w = 2 << (cc >> 5);
    const int g0 = it * 64 + tq * 16;
    const int t0 = g0 & (PT - 1), b = g0 >> 11;
    const bf16_t* base = proj + (size_t)g0 * NPROJ + C_P + cc * 8;
    u32x4 rw[31];
#pragma unroll
    for (int j = 0; j < 15; ++j) { rw[j] = (u32x4){0u, 0u, 0u, 0u}; if (t0 > 0 && 15 - j < w) rw[j] = *(const GAS u32x4*)(base - (ptrdiff_t)(15 - j) * NPROJ); }
#pragma unroll
    for (int j = 15; j < 31; ++j) rw[j] = *(const GAS u32x4*)(base + (size_t)(j - 15) * NPROJ);
    float sum[8];
#pragma unroll
    for (int e = 0; e < 8; ++e) sum[e] = 0.f;
#pragma unroll
    for (int j = 0; j < 15; ++j) { float f[8]; unpack8(rw[j], f);
#pragma unroll
        for (int e = 0; e < 8; ++e) sum[e] += f[e]; }
#pragma unroll
    for (int i = 0; i < 16; ++i) {
        const int t = t0 + i; float f[8]; unpack8(rw[15 + i], f);
        const float inv = 1.f / (float)min(t + 1, w);
        float o[8];
#pragma unroll
        for (int e = 0; e < 8; ++e) { sum[e] += f[e]; o[e] = sum[e] * inv - f[e]; }
        u32x4 ow; ow.x = pk2(o[0], o[1]); ow.y = pk2(o[2], o[3]); ow.z = pk2(o[4], o[5]); ow.w = pk2(o[6], o[7]);
        *(GAS u32x4*)((bf16_t*)(P.ws + WS_POOLED) + (size_t)(g0 + i) * D + cc * 8) = ow;
        if (t >= PT - 15) { float* po = P.out + O_PP + ((size_t)(l * PB + b) * 15 + (t - (PT - 15))) * 1024 + cc * 8;
            *(f32x4*)po = (f32x4){f[0], f[1], f[2], f[3]}; *(GAS f32x4*)(po + 4) = (f32x4){f[4], f[5], f[6], f[7]}; }
        const u32x4 lv = (w == 2) ? rw[14 + i] : (w == 4) ? rw[12 + i] : (w == 8) ? rw[8 + i] : rw[i];
        float f2[8]; unpack8(lv, f2);
#pragma unroll
        for (int e = 0; e < 8; ++e) sum[e] -= f2[e];
    }
}
DI void pool_sample_item(const Params& P, int l, int it) {
    int tid_ = threadIdx.x; asm volatile("" : "+v"(tid_));
    const int tid = tid_;
    const bf16_t* proj = (const bf16_t*)(P.ws + WS_PROJ);
    const int cc = tid & 127, b = it * 4 + (tid >> 7), w = 2 << (cc >> 5);
    const float* buf = P.in[I_SP] + ((size_t)(l * SB + b) * 15) * 1024 + cc * 8;
    const int row0 = MP + b * 8;
    f32x4 fb[15][2]; u32x4 pr[8];
#pragma unroll
    for (int j = 0; j < 15; ++j) { fb[j][0] = (f32x4){0.f, 0.f, 0.f, 0.f}; fb[j][1] = fb[j][0];
        if (j >= 8 || w == 16) { fb[j][0] = *(const GAS f32x4*)(buf + (size_t)j * 1024); fb[j][1] = *(const GAS f32x4*)(buf + (size_t)j * 1024 + 4); } }
#pragma unroll
    for (int t = 0; t < 8; ++t) pr[t] = *(const GAS u32x4*)(proj + (size_t)(row0 + t) * NPROJ + C_P + cc * 8);
    float* po = P.out + O_PS + ((size_t)(l * SB + b) * 15) * 1024 + cc * 8;
#pragma unroll
    for (int i = 0; i < 7; ++i) { *(GAS f32x4*)(po + (size_t)i * 1024) = fb[8 + i][0]; *(GAS f32x4*)(po + (size_t)i * 1024 + 4) = fb[8 + i][1]; }
    float full[23][8];
#pragma unroll
    for (int j = 0; j < 15; ++j) { full[j][0] = fb[j][0][0]; full[j][1] = fb[j][0][1]; full[j][2] = fb[j][0][2]; full[j][3] = fb[j][0][3]; full[j][4] = fb[j][1][0]; full[j][5] = fb[j][1][1]; full[j][6] = fb[j][1][2]; full[j][7] = fb[j][1][3]; }
#pragma unroll
    for (int t = 0; t < 8; ++t) unpack8(pr[t], full[15 + t]);
    float sum[8];
#pragma unroll
    for (int e = 0; e < 8; ++e) sum[e] = 0.f;
#pragma unroll
    for (int j = 0; j < 15; ++j) { const bool in = (15 - j) < w;
#pragma unroll
        for (int e = 0; e < 8; ++e) sum[e] += in ? full[j][e] : 0.f; }
    const float inv = 1.f / (float)w;
#pragma unroll
    for (int t = 0; t < 8; ++t) {
        float o[8];
#pragma unroll
        for (int e = 0; e < 8; ++e) { sum[e] += full[15 + t][e]; o[e] = sum[e] * inv - full[15 + t][e]; }
        u32x4 ow; ow.x = pk2(o[0], o[1]); ow.y = pk2(o[2], o[3]); ow.z = pk2(o[4], o[5]); ow.w = pk2(o[6], o[7]);
        *(GAS u32x4*)((bf16_t*)(P.ws + WS_POOLED) + (size_t)(row0 + t) * D + cc * 8) = ow;
        *(GAS f32x4*)(po + (size_t)(7 + t) * 1024) = (f32x4){full[15 + t][0], full[15 + t][1], full[15 + t][2], full[15 + t][3]};
        *(GAS f32x4*)(po + (size_t)(7 + t) * 1024 + 4) = (f32x4){full[15 + t][4], full[15 + t][5], full[15 + t][6], full[15 + t][7]};
#pragma unroll
        for (int e = 0; e < 8; ++e) { const float lv = (w == 2) ? full[14 + t][e] : (w == 4) ? full[12 + t][e] : (w == 8) ? full[8 + t][e] : full[t][e]; sum[e] -= lv; }
    }
}

DI void sgu_sample_item(const Params& P, ldsp lds, int l, int b) {
    int tid_ = threadIdx.x; asm volatile("" : "+v"(tid_));
    const int tid = tid_, lane = tid & 63, wave = __builtin_amdgcn_readfirstlane(tid >> 6);
    const bf16_t* proj = (const bf16_t*)(P.ws + WS_PROJ);
    LAS float* VS = (LAS float*)lds;
    __syncthreads();
    const size_t row = (size_t)(MP + b * 8 + wave);
    {   float f[16];
        unpack8(*(const GAS u32x4*)(proj + row * NPROJ + C_VA + 8 * lane), f); unpack8(*(const GAS u32x4*)(proj + row * NPROJ + C_VA + 512 + 8 * lane), f + 8);
        float s = 0.f;
#pragma unroll
        for (int j = 0; j < 16; ++j) s += f[j];
        const float mu = wave_sum(s) * (1.f / D); float q = 0.f;
#pragma unroll
        for (int j = 0; j < 16; ++j) { const float d = f[j] - mu; q += d * d; }
        const float rstd = rsqrtf(wave_sum(q) * (1.f / D) + EPS);
        float* vo = P.out + O_VS + ((size_t)(l * SB + b) * 8 + wave) * 1024;
#pragma unroll
        for (int hf = 0; hf < 2; ++hf) { const int c0 = hf * 512 + 8 * lane;
#pragma unroll
            for (int j = 0; j < 8; ++j) { const float y = (f[hf * 8 + j] - mu) * rstd * P.in[I_LNG][l * D + c0 + j] + P.in[I_LNB][l * D + c0 + j]; VS[wave * 1024 + c0 + j] = y; vo[c0 + j] = y; } }
    }
    __syncthreads();
    {   const int i = wave;
#pragma unroll
        for (int hf = 0; hf < 2; ++hf) { const int c0 = hf * 512 + 8 * lane, g = c0 >> 8;
            const float* wrow = P.in[I_WSGU] + ((size_t)(l * 4 + g) * 128 + i) * 128;
            const float bs = P.in[I_BSGU][(l * 4 + g) * 128 + i];
            float s[8];
#pragma unroll
            for (int j = 0; j < 8; ++j) s[j] = bs;
            for (int jj = 0; jj <= i; ++jj) { const float wv = wrow[jj];
#pragma unroll
                for (int j = 0; j < 8; ++j) s[j] += wv * VS[jj * 1024 + c0 + j]; }
            float uu[8], zz[8]; unpack8(*(const GAS u32x4*)(proj + row * NPROJ + C_U + c0), uu); unpack8(*(const GAS u32x4*)(proj + row * NPROJ + C_ZA + c0), zz);
            u32x4 o; o.x = pk2(uu[0] * s[0] * zz[0], uu[1] * s[1] * zz[1]); o.y = pk2(uu[2] * s[2] * zz[2], uu[3] * s[3] * zz[3]);
            o.z = pk2(uu[4] * s[4] * zz[4], uu[5] * s[5] * zz[5]); o.w = pk2(uu[6] * s[6] * zz[6], uu[7] * s[7] * zz[7]);
            *(GAS u32x4*)((bf16_t*)(P.ws + WS_Y) + row * D + c0) = o; }
    }
}

#define TILE_LOAD(regs, src, ld) do { _Pragma("unroll") for (int _i = 0; _i < 8; ++_i) regs[_i] = *(const GAS u32x4*)((src) + (size_t)(krow + 16 * _i) * (ld) + kcc * 8); } while (0)
#define TILE_STORE(regs, dst, stride) do { _Pragma("unroll") for (int _i = 0; _i < 8; ++_i) *(LAS u32x4*)((dst) + (krow + 16 * _i) * (stride) + kcc * 16) = regs[_i]; } while (0)
constexpr int HSS = 260;

DI void sgu_item(const Params& P, ldsp lds, int l, int it) {
    int tid_ = threadIdx.x; asm volatile("" : "+v"(tid_));
    const int tid = tid_, lane = tid & 63, wave = __builtin_amdgcn_readfirstlane(tid >> 6);
    unsigned char* ws = P.ws; asm volatile("" : "+s"(ws));
    const bf16_t* proj = (const bf16_t*)(ws + WS_PROJ);
    const int g = it & 3, bn = it >> 2, row0 = bn * 128;
    const ldsp WT = lds + 73728;
    const ldsp VN = lds;
    LAS float* HS = (LAS float*)lds;
    const int krow = tid >> 5, kcc = tid & 31;
    __syncthreads();
    {   const float* W = P.in[I_WSGU] + (size_t)(l * 4 + g) * 16384;
#pragma unroll
        for (int ii = 0; ii < 4; ++ii) { const int id = tid + 512 * ii, i = id >> 4, j0 = (id & 15) * 8;
            const f32x4 a = *(const GAS f32x4*)(W + i * 128 + j0), bq = *(const GAS f32x4*)(W + i * 128 + j0 + 4);
            float f[8] = {a[0], a[1], a[2], a[3], bq[0], bq[1], bq[2], bq[3]};
#pragma unroll
            for (int e = 0; e < 8; ++e) f[e] = (j0 + e <= i) ? f[e] : 0.f;
            u32x4 o; o.x = pk2(f[0], f[1]); o.y = pk2(f[2], f[3]); o.z = pk2(f[4], f[5]); o.w = pk2(f[6], f[7]);
            *(LAS u32x4*)(WT + i * 272 + j0 * 2) = o; }
        const int ch0 = g * 256 + kcc * 8;
        float lg[8], lb[8];
#pragma unroll
        for (int e = 0; e < 8; ++e) { lg[e] = P.in[I_LNG][l * D + ch0 + e]; lb[e] = P.in[I_LNB][l * D + ch0 + e]; }
        const float* lns = (const float*)(ws + WS_LNS);
        u32x4 rv[8]; TILE_LOAD(rv, proj + (size_t)row0 * NPROJ + C_VA + g * 256, NPROJ);
#pragma unroll
        for (int ii = 0; ii < 8; ++ii) { const int r = krow + 16 * ii;
            float f[8]; unpack8(rv[ii], f);
            const f32x2 st = *(const GAS f32x2*)(lns + (size_t)(row0 + r) * 2);
#pragma unroll
            for (int e = 0; e < 8; ++e) f[e] = (f[e] - st[0]) * st[1] * lg[e] + lb[e];
            u32x4 o; o.x = pk2(f[0], f[1]); o.y = pk2(f[2], f[3]); o.z = pk2(f[4], f[5]); o.w = pk2(f[6], f[7]);
            *(LAS u32x4*)(VN + r * XS + kcc * 16) = o; }
    }
    __syncthreads();
    u32x4 ru[8], rz[8];
    TILE_LOAD(ru, proj + (size_t)row0 * NPROJ + C_U + g * 256, NPROJ);
    TILE_LOAD(rz, proj + (size_t)row0 * NPROJ + C_ZA + g * 256, NPROJ);
    const int ib = wave & 3, chh = wave >> 2, h5 = lane >> 5;
    f32x16 acc[4];
#pragma unroll
    for (int tt = 0; tt < 4; ++tt)
#pragma unroll
        for (int r = 0; r < 16; ++r) acc[tt][r] = 0.f;
    for (int kk = 0; kk < 2 * (ib + 1); ++kk) {
        const bf16x8 a = frag_row(WT, 272, 32 * ib, 16 * kk, lane);
#pragma unroll
        for (int tt = 0; tt < 4; ++tt) { const bf16x8 bb = frag_tr(VN, XS, 16 * kk, 128 * chh + 32 * tt, lane); acc[tt] = MFMA32(a, bb, acc[tt]); }
    }
    __syncthreads();
    const float* bsg = P.in[I_BSGU] + (l * 4 + g) * 128;
#pragma unroll
    for (int r = 0; r < 16; ++r) { const int i = 32 * ib + crow(r, h5); const float bs = bsg[i];
#pragma unroll
        for (int tt = 0; tt < 4; ++tt) HS[i * HSS + 128 * chh + 32 * tt + (lane & 31)] = acc[tt][r] + bs; }
    __syncthreads();
    bf16_t* ya = (bf16_t*)(ws + WS_Y);
#pragma unroll
    for (int ii = 0; ii < 8; ++ii) { const int r = krow + 16 * ii;
        const f32x4 s0 = *(const LAS f32x4*)(HS + r * HSS + kcc * 8), s1 = *(const LAS f32x4*)(HS + r * HSS + kcc * 8 + 4);
        float uu[8], zz[8]; unpack8(ru[ii], uu); unpack8(rz[ii], zz);
        u32x4 o; o.x = pk2(uu[0] * s0[0] * zz[0], uu[1] * s0[1] * zz[1]); o.y = pk2(uu[2] * s0[2] * zz[2], uu[3] * s0[3] * zz[3]);
        o.z = pk2(uu[4] * s1[0] * zz[4], uu[5] * s1[1] * zz[5]); o.w = pk2(uu[6] * s1[2] * zz[6], uu[7] * s1[3] * zz[7]);
        *(GAS u32x4*)(ya + (size_t)(row0 + r) * D + g * 256 + kcc * 8) = o; }
}

DI void pool_mix_item(const Params& P, ldsp lds, int l, int it) {
    int tid_ = threadIdx.x; asm volatile("" : "+v"(tid_));
    const int tid = tid_, lane = tid & 63, wave = __builtin_amdgcn_readfirstlane(tid >> 6);
    unsigned char* ws = P.ws; asm volatile("" : "+s"(ws));
    const bf16_t* proj = (const bf16_t*)(ws + WS_PROJ);
    const int g = it & 3, row0 = (it >> 2) * 128;
    const ldsp QT = lds;
    const ldsp XT = lds + 67584;
    LAS float* HS = (LAS float*)lds;
    const int krow = tid >> 5, kcc = tid & 31;
    const float* W = P.in[I_WPOOL] + (size_t)(l * 4 + g) * 65536;
    const bf16_t* pooled = (const bf16_t*)(ws + WS_POOLED);
    __syncthreads();
    u32x4 rq[8], rx[8];
    TILE_LOAD(rq, pooled + (size_t)row0 * D + g * 256, D);
#define WLOAD(half) do { _Pragma("unroll") for (int _i = 0; _i < 8; ++_i) { const float* wp = W + (size_t)((half) * 128 + krow + 16 * _i) * 256 + kcc * 8; \
        const f32x4 a = *(const f32x4*)wp, bq = *(const GAS f32x4*)(wp + 4); rx[_i].x = pk2(a[0], a[1]); rx[_i].y = pk2(a[2], a[3]); rx[_i].z = pk2(bq[0], bq[1]); rx[_i].w = pk2(bq[2], bq[3]); } } while (0)
    WLOAD(0);
    TILE_STORE(rq, QT, TS); TILE_STORE(rx, XT, XS);
    __syncthreads();
    WLOAD(1);
    const int tb = wave & 3, dh = wave >> 2, h5 = lane >> 5;
    f32x16 O[4];
#pragma unroll
    for (int tt = 0; tt < 4; ++tt)
#pragma unroll
        for (int r = 0; r < 16; ++r) O[tt][r] = 0.f;
#pragma unroll 1
    for (int half = 0; half < 2; ++half) {
        if (half == 1) { __syncthreads(); TILE_STORE(rx, XT, XS); __syncthreads();
            TILE_LOAD(rx, proj + (size_t)row0 * NPROJ + C_ZC + g * 256, NPROJ); }
#pragma unroll 2
        for (int kk = 0; kk < 8; ++kk) {
            const bf16x8 a = frag_row(QT, TS, 32 * tb, half * 128 + 16 * kk, lane);
#pragma unroll
            for (int tt = 0; tt < 4; ++tt) { const bf16x8 bb = frag_tr(XT, XS, 16 * kk, 128 * dh + 32 * tt, lane); O[tt] = MFMA32(a, bb, O[tt]); }
        }
    }
#undef WLOAD
    __syncthreads();
#pragma unroll
    for (int tt = 0; tt < 4; ++tt) { const int d = 128 * dh + 32 * tt + (lane & 31); const float ps = P.in[I_PSCALE][l * D + g * 256 + d];
#pragma unroll
        for (int r = 0; r < 16; ++r) HS[(32 * tb + crow(r, h5)) * HSS + d] = O[tt][r] * ps; }
    __syncthreads();
    bf16_t* yc = (bf16_t*)(ws + WS_Y) + 2 * (size_t)M * D;
#pragma unroll
    for (int ii = 0; ii < 8; ++ii) { const int r = krow + 16 * ii;
        const f32x4 s0 = *(const LAS f32x4*)(HS + r * HSS + kcc * 8), s1 = *(const LAS f32x4*)(HS + r * HSS + kcc * 8 + 4);
        float zz[8]; unpack8(rx[ii], zz);
        u32x4 o; o.x = pk2(s0[0] * zz[0], s0[1] * zz[1]); o.y = pk2(s0[2] * zz[2], s0[3] * zz[3]); o.z = pk2(s1[0] * zz[4], s1[1] * zz[5]); o.w = pk2(s1[2] * zz[6], s1[3] * zz[7]);
        *(GAS u32x4*)(yc + (size_t)(row0 + r) * D + g * 256 + kcc * 8) = o; }
}

DI void m3_items(const Params& P, ldsp lds, int l, int G) {
    int tid_ = threadIdx.x; asm volatile("" : "+v"(tid_));
    const int tid = tid_, lane = tid & 63, wave = __builtin_amdgcn_readfirstlane(tid >> 6);
    unsigned char* ws = P.ws; asm volatile("" : "+s"(ws));
    const bf16_t* proj = (const bf16_t*)(ws + WS_PROJ);
    const int krow = tid >> 5, kcc = tid & 31;
    u32x4 rq[8], rx[8];
#pragma unroll 1
    for (int it = blockIdx.x; it < 512; it += G) {
    int ti_ = tid; asm volatile("" : "+v"(ti_));
    const int tid = ti_, lane = tid & 63, krow = tid >> 5, kcc = tid & 31;
    const int bh = it >> 4, c = it & 15, b = bh >> 2, hh = bh & 3;
    const int row0 = b * PT + c * 128;
    const ldsp QT = lds;
    const ldsp XT = lds + 67584;
    LAS float* TA = (LAS float*)(lds + 141312);
    LAS float* TM = TA + 128;
    LAS float* TW = TM + 128;
    LAS float* TF = TW + 128;
    LAS float* TN = TF + 128;
    LAS float* DW = TN + 256;
    LAS float* HS = (LAS float*)lds;
    const bf16_t* prow = proj + (size_t)row0 * NPROJ + hh * 256;
    __syncthreads();
    const float* tok = (const float*)(ws + WS_TOK);
    if (tid < 128) { const size_t o = (size_t)bh * 2048 + c * 128 + tid; TA[tid] = tok[o]; TM[tid] = tok[(size_t)32 * 2048 + o]; TW[tid] = tok[(size_t)64 * 2048 + o]; TF[tid] = tok[(size_t)96 * 2048 + o]; }
    else if (tid < 384) TN[tid - 128] = ((const float*)(ws + WS_NST))[(size_t)(bh * NCH + c) * 256 + tid - 128];
    const bf16_t* cst = (const bf16_t*)(ws + WS_CST) + (size_t)(bh * NCH + c) * 65536;
    TILE_LOAD(rq, prow + C_Q, NPROJ); TILE_LOAD(rx, cst, 256);
    TILE_STORE(rq, QT, TS); TILE_STORE(rx, XT, XS);
    __syncthreads();
    TILE_LOAD(rx, cst + 128 * 256, 256);
    TILE_LOAD(rq, prow + C_K, NPROJ);
    const int tb = wave & 3, dh = wave >> 2, h5 = lane >> 5;
    f32x16 O[4];
#pragma unroll
    for (int tt = 0; tt < 4; ++tt)
#pragma unroll
        for (int r = 0; r < 16; ++r) O[tt][r] = 0.f;
#pragma unroll 1
    for (int half = 0; half < 2; ++half) {
        if (half == 1) { __syncthreads(); TILE_STORE(rx, XT, XS); __syncthreads(); TILE_LOAD(rx, prow + C_V, NPROJ); }
#pragma unroll 2
        for (int kk = 0; kk < 8; ++kk) {
            const bf16x8 a = frag_row(QT, TS, 32 * tb, half * 128 + 16 * kk, lane);
#pragma unroll
            for (int tt = 0; tt < 4; ++tt) { const bf16x8 bb = frag_tr(XT, XS, 16 * kk, 128 * dh + 32 * tt, lane); O[tt] = MFMA32(a, bb, O[tt]); }
        }
    }
#pragma unroll
    for (int r = 0; r < 16; ++r) { const float wi = TW[32 * tb + crow(r, h5)];
#pragma unroll
        for (int tt = 0; tt < 4; ++tt) O[tt][r] *= wi; }
    __syncthreads();
    TILE_STORE(rq, XT, TS);
    __syncthreads();
    bf16x8 pf[4][2];
    float denl = 0.f, qn = 0.f;
    const int tq = 32 * tb + (lane & 31);
    const float Mq = TM[tq];
#pragma unroll
    for (int sb = 0; sb < 4; ++sb) {
        if (sb <= tb) {
            f32x16 S;
#pragma unroll
            for (int r = 0; r < 16; ++r) S[r] = 0.f;
#pragma unroll 2
            for (int kk = 0; kk < 16; ++kk) {
                const bf16x8 a = frag_row(XT, TS, 32 * sb, 16 * kk, lane), bb = frag_row(QT, TS, 32 * tb, 16 * kk, lane);
                S = MFMA32(a, bb, S);
                if (sb == 0) {
#pragma unroll
                    for (int j = 0; j < 8; ++j) qn += bf2f((bf16_t)bb[j]) * TN[16 * kk + 8 * h5 + j]; }
            }
            float pw[16];
#pragma unroll
            for (int r = 0; r < 16; ++r) { const int sp = 32 * sb + crow(r, h5);
                float wgt = __expf(TA[sp] - Mq); wgt = (sp <= tq) ? wgt : 0.f; pw[r] = S[r] * wgt; denl += pw[r]; }
#pragma unroll
            for (int s2 = 0; s2 < 2; ++s2) { u32x4 w; w.x = pk2(pw[8 * s2], pw[8 * s2 + 1]); w.y = pk2(pw[8 * s2 + 2], pw[8 * s2 + 3]); w.z = pk2(pw[8 * s2 + 4], pw[8 * s2 + 5]); w.w = pk2(pw[8 * s2 + 6], pw[8 * s2 + 7]);
                pf[sb][s2] = __builtin_bit_cast(bf16x8, w); }
        }
    }
    qn += __shfl_xor(qn, 32); denl += __shfl_xor(denl, 32);
    __syncthreads();
    TILE_STORE(rx, XT, XS);
    __syncthreads();
#pragma unroll
    for (int sb = 0; sb < 4; ++sb) {
        if (sb <= tb) {
#pragma unroll
            for (int s2 = 0; s2 < 2; ++s2)
#pragma unroll
                for (int tt = 0; tt < 4; ++tt) { const bf16x8 bb = frag_tr_perm(XT, XS, 32 * sb + 16 * s2, 128 * dh + 32 * tt, lane); O[tt] = MFMA32(pf[sb][s2], bb, O[tt]); }
        }
    }
    if (lane < 32) DW[wave * 32 + lane] = TW[tq] * qn + denl;
    float rinv[16];
#pragma unroll
    for (int r = 0; r < 16; ++r) { const int tl = crow(r, h5); const float d = DW[wave * 32 + tl]; rinv[r] = 1.f / fmaxf(fabsf(d), TF[32 * tb + tl]); }
    __syncthreads();
#pragma unroll
    for (int r = 0; r < 16; ++r) { const int t = 32 * tb + crow(r, h5);
#pragma unroll
        for (int tt = 0; tt < 4; ++tt) HS[t * HSS + 128 * dh + 32 * tt + (lane & 31)] = O[tt][r] * rinv[r]; }
    u32x2 gow[16], gzw[16];
#pragma unroll
    for (int i = 0; i < 16; ++i) { const size_t row = (size_t)(row0 + 16 * wave + i);
        gow[i] = *(const GAS u32x2*)(proj + row * NPROJ + C_OB + hh * 256 + 4 * lane); gzw[i] = *(const GAS u32x2*)(proj + row * NPROJ + C_ZB + hh * 256 + 4 * lane); }
    __syncthreads();
    const f32x4 g4 = *(const GAS f32x4*)(P.in[I_MNG] + l * D + hh * 256 + 4 * lane);
#pragma unroll
    for (int i = 0; i < 16; ++i) { const int t = 16 * wave + i; const size_t row = (size_t)(row0 + t);
        const f32x4 hv = *(const LAS f32x4*)(HS + t * HSS + 4 * lane);
        const u32x2 ow = gow[i], zw = gzw[i];
        const f32x4 hb = hv * (f32x4){bf_lo(ow.x), bf_hi(ow.x), bf_lo(ow.y), bf_hi(ow.y)};
        const float mu = wave_sum(hb[0] + hb[1] + hb[2] + hb[3]) * (1.f / 256.f);
        const f32x4 dv = hb - mu;
        const float rstd = rsqrtf(wave_sum(dv[0] * dv[0] + dv[1] * dv[1] + dv[2] * dv[2] + dv[3] * dv[3]) * (1.f / 256.f) + EPS);
        const f32x4 y = dv * rstd * g4 * (f32x4){bf_lo(zw.x), bf_hi(zw.x), bf_lo(zw.y), bf_hi(zw.y)};
        u32x2 o; o.x = pk2(y[0], y[1]); o.y = pk2(y[2], y[3]);
        *(GAS u32x2*)((bf16_t*)(ws + WS_Y) + ((size_t)M + row) * D + hh * 256 + 4 * lane) = o; }
    }
}

DI void phase_final(const Params& P, int G) {
    int tid_ = threadIdx.x; asm volatile("" : "+v"(tid_));
    const int tid = tid_, lane = tid & 63, wave = __builtin_amdgcn_readfirstlane(tid >> 6);
    f32x4 g4[4];
#pragma unroll
    for (int j = 0; j < 4; ++j) g4[j] = *(const GAS f32x4*)(P.in[I_FNG] + 4 * (lane + 64 * j));
    for (int row0 = blockIdx.x * 8 + wave; row0 < M; row0 += G * 8 * 2) {
        f32x4 v[2][4];
#pragma unroll
        for (int k = 0; k < 2; ++k) { const int row = row0 + k * G * 8;
            if (row < MP) {
#pragma unroll
                for (int j = 0; j < 4; ++j) v[k][j] = ((const GAS f32x4*)(P.out + O_Y + (size_t)row * D))[lane + 64 * j]; }
            else if (row < M) { const float* po = (const float*)(P.ws + WS_PO) + (size_t)(row - MP) * D; const float* x1 = (const float*)(P.ws + WS_X1) + (size_t)row * D;
#pragma unroll
                for (int j = 0; j < 4; ++j) v[k][j] = ((const GAS f32x4*)x1)[lane + 64 * j] + ((const GAS f32x4*)po)[lane + 64 * j] + ((const GAS f32x4*)(po + (size_t)MS * D))[lane + 64 * j] + ((const GAS f32x4*)(po + 2 * (size_t)MS * D))[lane + 64 * j]; } }
#pragma unroll
        for (int k = 0; k < 2; ++k) { const int row = row0 + k * G * 8;
            if (row < M) { float ss = 0.f;
#pragma unroll
                for (int j = 0; j < 4; ++j) ss += v[k][j][0] * v[k][j][0] + v[k][j][1] * v[k][j][1] + v[k][j][2] * v[k][j][2] + v[k][j][3] * v[k][j][3];
                const float rms = rsqrtf(wave_sum(ss) * (1.f / D) + EPS);
                float* xr = P.out + O_Y + (size_t)row * D;
#pragma unroll
                for (int j = 0; j < 4; ++j) ((GAS f32x4*)xr)[lane + 64 * j] = v[k][j] * rms * g4[j]; } }
    }
}


#define XB_TMO      128
#define XB_XCNT(j)  (256  + 64 * (j))
#define XB_XSUB(j)  (1280 + 64 * (j))
#define XB_XGEN(j)  (2304 + 64 * (j))
#define XB_TOP      3328
#define XB_TOPGEN   3392
#define XCD_BAR_WORDS 3456
#define XB_SPIN_CAP (1u << 22)
DI unsigned xb_ld(unsigned* p)              { return __hip_atomic_load(p, __ATOMIC_RELAXED, __HIP_MEMORY_SCOPE_AGENT); }
DI unsigned xb_add(unsigned* p, unsigned v) { return __hip_atomic_fetch_add(p, v, __ATOMIC_RELAXED, __HIP_MEMORY_SCOPE_AGENT); }
DI unsigned xb_xcc_id() { return (unsigned)__builtin_amdgcn_s_getreg((3 << 11) | 20) & 0xFu; }
#define XB_SPIN(cond, bar) do { unsigned _sp = 0; while (cond) { __builtin_amdgcn_s_sleep(1); \
    if ((++_sp & 255u) == 0u) { if (xb_ld(&(bar)[XB_TMO])) break; if (_sp > XB_SPIN_CAP) { atomicAdd(&(bar)[XB_TMO], 1u); break; } } } } while (0)
struct XcdBarrier { unsigned* bar; unsigned x; volatile LAS unsigned* st; };
DI XcdBarrier xcd_barrier_post(unsigned* bar, volatile LAS unsigned* st) {
    XcdBarrier b; b.bar = bar; b.x = xb_xcc_id(); b.st = st;
    if (threadIdx.x == 0) (void)xb_add(&bar[XB_XCNT(b.x)], 1u);
    return b;
}
DI void xcd_barrier_complete(unsigned* bar, unsigned x, unsigned& nloc, unsigned& nx) {
    const unsigned G = gridDim.x * gridDim.y * gridDim.z;
    unsigned sum, cnt, mine, sp = 0u;
    for (;;) {
        sum = 0u; cnt = 0u; mine = 0u;
#pragma unroll
        for (unsigned j = 0; j < 16; ++j) { const unsigned c = xb_ld(&bar[XB_XCNT(j)]); sum += c; cnt += (c > 0u) ? 1u : 0u; mine = (j == x) ? c : mine; }
        if (sum == G) break;
        __builtin_amdgcn_s_sleep(1);
        if ((++sp & 255u) == 0u) { if (xb_ld(&bar[XB_TMO])) break; if (sp > XB_SPIN_CAP) { atomicAdd(&bar[XB_TMO], 1u); break; } }
    }
    nloc = mine > 0u ? mine : 1u; nx = cnt > 0u ? cnt : 1u;
}
DI void xcd_barrier(const XcdBarrier& b) {
    asm volatile("s_waitcnt vmcnt(0)" ::: "memory");
    __syncthreads();
    if (threadIdx.x == 0) {
        unsigned* bar = b.bar;
        __builtin_amdgcn_s_waitcnt(0);
        unsigned nloc = b.st[0], nx = b.st[1];
        if (nloc == 0u) { xcd_barrier_complete(bar, b.x, nloc, nx); b.st[0] = nloc; b.st[1] = nx; }
        const unsigned old = xb_add(&bar[XB_XSUB(b.x)], 1u);
        const unsigned gen = old / nloc;
        if (old + 1u == (gen + 1u) * nloc) {
            __builtin_amdgcn_fence(__ATOMIC_RELEASE, "agent");
            asm volatile("s_waitcnt vmcnt(0)" ::: "memory");
            const unsigned og = xb_add(&bar[XB_TOP], 1u);
            const unsigned tg = og / nx;
            if (og + 1u == (tg + 1u) * nx) xb_add(&bar[XB_TOPGEN], 1u);
            else XB_SPIN(xb_ld(&bar[XB_TOPGEN]) == tg, bar);
            __builtin_amdgcn_fence(__ATOMIC_ACQUIRE, "agent");
            xb_add(&bar[XB_XGEN(b.x)], 1u);
            asm volatile("s_waitcnt vmcnt(0)" ::: "memory");
        } else {
            XB_SPIN(xb_ld(&bar[XB_XGEN(b.x)]) == gen, bar);
            __builtin_amdgcn_fence(__ATOMIC_ACQUIRE, "agent");
            asm volatile("s_waitcnt vmcnt(0)" ::: "memory");
        }
    }
    __syncthreads();
}

#ifndef REP_PRO
#define REP_PRO 1
#endif
#ifndef REP_N
#define REP_N 1
#endif
#ifndef REP_G1
#define REP_G1 1
#endif
#ifndef REP_M
#define REP_M 1
#endif
#ifndef REP_S
#define REP_S 1
#endif
#ifndef REP_G3
#define REP_G3 1
#endif
#ifndef REP_G4
#define REP_G4 1
#endif
__global__ void __launch_bounds__(512, 2) fwd_kernel(Params P) {
    extern __shared__ __attribute__((aligned(16))) unsigned char lds_raw[];
    const ldsp lds0 = (ldsp)lds_raw;
    cg::grid_group grid = cg::this_grid();
    const int G = gridDim.x;
    volatile LAS unsigned* MISC = (volatile LAS unsigned*)(lds0 + LDS_BYTES - 64);
    if (threadIdx.x < 16) MISC[threadIdx.x] = 0u;
    __syncthreads();
    const XcdBarrier xbar = xcd_barrier_post((unsigned*)P.ws, MISC);
    const int lo = P.ph_lo, hi = P.ph_hi;
    int ph = 0;
#define RUN(k) (lo <= (k) && (k) < hi)
#define SEAM(k) do { if (RUN(k) && RUN((k) + 1)) xcd_barrier(xbar); } while (0)
    for (int rep = 0; rep < REP_PRO; ++rep) { if (rep) xcd_barrier(xbar);
    if (RUN(0)) phase_prologue(P, lds0, G);
    }
    if (P.ph_hi > 1000) grid.sync();
    SEAM(0);
#pragma unroll 1
    for (int l = 0; l < 2; ++l) {
        ph = 1 + 6 * l;

        for (int rep = 0; rep < REP_N; ++rep) { if (rep) xcd_barrier(xbar);
        if (RUN(ph)) { unsigned char* ws = P.ws; asm volatile("" : "+s"(ws)); ldsp lds = lds0; asm volatile("" : "+s"(lds)); phase_norm(P, lds, G, l); }
        }
        SEAM(ph);
        ++ph;
        for (int rep = 0; rep < REP_G1; ++rep) { if (rep) xcd_barrier(xbar);
        if (RUN(ph)) {
            unsigned char* ws = P.ws; asm volatile("" : "+s"(ws)); ldsp lds = lds0; asm volatile("" : "+s"(lds));
            pg8::Gemm g{(const bf16_t*)(ws + WS_H), (const bf16_t*)(ws + WS_WIN) + (size_t)l * NPROJ * D, D, D, D, 0, 0};
            pg8::Sched S; S.init(M, NPROJ, 1, 0, G, (int)blockIdx.x);
            pg8::EpiProj E{(bf16_t*)(ws + WS_PROJ)};
            pg8::gemm_phase<pg8::EpiProj>(lds, g, S, E);
        }
        }
        SEAM(ph);
        ++ph;
        for (int rep = 0; rep < REP_M; ++rep) { if (rep) xcd_barrier(xbar);
        if (RUN(ph)) {
            unsigned char* ws = P.ws; asm volatile("" : "+s"(ws)); ldsp lds = lds0; asm volatile("" : "+s"(lds));
            {   const int grp = (int)((blockIdx.x >> 6) & 3);
                const int ord = grp == 0 ? 0x210 : grp == 1 ? 0x021 : grp == 2 ? 0x120 : 0x201;
#pragma unroll 1
                for (int pass = 0; pass < 3; ++pass) {
                    const int kind = (ord >> (4 * pass)) & 15;
                    if (kind == 0) {
                        for (int it = blockIdx.x; it < 256; it += G) { const int x = it & 7, j = it >> 3; scan_item(P, lds, l, ((4 * x + (j >> 3)) << 3) + (j & 7)); }
                    } else if (kind == 1) {
                        for (int it = blockIdx.x; it < SB * 4; it += G) sample_mlstm_item(P, lds, l, it);
                    } else {
                        lnstats_rows(P, G);
                        for (int it = blockIdx.x; it < MP / 64; it += G) pool_prompt_item(P, l, it);
                        for (int it = (int)(G - 1 - blockIdx.x); it < SB / 4; it += G) pool_sample_item(P, l, it);
                        for (int it = (int)((blockIdx.x + G - 64) % G); it < SB; it += G) sgu_sample_item(P, lds, l, it);
                    }
                }
            }
            __syncthreads();
        }
        }
        SEAM(ph);
        ++ph;
        for (int rep = 0; rep < REP_S; ++rep) { if (rep) xcd_barrier(xbar);
        if (RUN(ph)) {
            unsigned char* ws = P.ws; asm volatile("" : "+s"(ws)); ldsp lds = lds0; asm volatile("" : "+s"(lds));
            {   const int rot = (int)((blockIdx.x >> 5) % 3);
#pragma unroll 1
                for (int pass = 0; pass < 3; ++pass) {
                    const int kind = (pass + rot) % 3;
                    if (kind == 0) m3_items(P, lds, l, G);
                    else if (kind == 1) { for (int it = blockIdx.x; it < 512; it += G) sgu_item(P, lds, l, it); }
                    else { for (int it = blockIdx.x; it < (M / 128) * 4; it += G) pool_mix_item(P, lds, l, it); }
                }
            }
            __syncthreads();
        }
        }
        SEAM(ph);
        ++ph;
        for (int rep = 0; rep < REP_G3; ++rep) { if (rep) xcd_barrier(xbar);
        if (RUN(ph)) {
            unsigned char* ws = P.ws; asm volatile("" : "+s"(ws)); ldsp lds = lds0; asm volatile("" : "+s"(lds));
            pg8::Gemm g{(const bf16_t*)(ws + WS_Y), (const bf16_t*)(ws + WS_WBR) + (size_t)l * 3 * D * D, D, D, D, (size_t)M * D * 2, (size_t)D * D * 2};
            pg8::Sched S; S.init(MP, D, 3, 3, G, (int)blockIdx.x);
            pg8::EpiMerge E{(bf16_t*)(ws + WS_MERGED), (bf16_t*)(ws + WS_PART), (const bf16_t*)(ws + WS_PROJ)};
            pg8::gemm_phase<pg8::EpiMerge>(lds, g, S, E);
        }
        }
        SEAM(ph);
        ++ph;
        for (int rep = 0; rep < REP_G4; ++rep) { if (rep) xcd_barrier(xbar);
        if (RUN(ph)) {
            unsigned char* ws = P.ws; asm volatile("" : "+s"(ws)); ldsp lds = lds0; asm volatile("" : "+s"(lds));
            const bf16_t* w3 = (const bf16_t*)(ws + WS_WOUT3) + (size_t)l * D * 3072;
            const float* X1 = (const float*)(ws + WS_X1);
            const float* modg = (const float*)(ws + WS_MOD) + (size_t)l * NB * 3072 + 2048;
            {   pg8::Gemm g{(const bf16_t*)(ws + WS_MERGED), w3, D, 3072, D, 0, 0};
                pg8::Sched S; S.init(MP, D, 1, 0, G, (int)blockIdx.x);
                pg8::EpiOut E{l == 0 ? P.in[I_XP] : X1, l == 0 ? P.in[I_XS] : X1 + (size_t)MP * D, l == 0 ? (float*)(ws + WS_X1) : P.out + O_Y, modg};
                pg8::gemm_phase<pg8::EpiOut>(lds, g, S, E); }
            {   pg8::Gemm g{(const bf16_t*)(ws + WS_PART), w3, 3072, 3072, D, 2048, 2048};
                pg8::Sched S; S.init(MS, D, 1, 4, G, (int)((blockIdx.x + 64) % G));
                pg8::EpiOutPart E{(float*)(ws + WS_PO), modg};
                pg8::gemm_phase<pg8::EpiOutPart>(lds, g, S, E); }
        }
        }
        SEAM(ph);
    }
    if (RUN(13)) phase_final(P, G);
#undef RUN
#undef SEAM
}

extern "C" void kernel_launch(void* const* d_in, const int* in_sizes, int n_in, void* d_out, int out_size, void* d_ws, size_t ws_size, hipStream_t stream) {
    static int grid = 0;
    if (grid == 0) {
        if (n_in != 25 || (size_t)out_size != O_END || ws_size < WS_END) { fprintf(stderr, "kernel_launch: unexpected sizes n_in %d out %d ws %zu (need %zu)\n", n_in, out_size, ws_size, (size_t)WS_END); grid = -1; return; }
        int dev = 0, cus = 0, per_cu = 0;
        hipGetDevice(&dev);
        hipDeviceGetAttribute(&cus, hipDeviceAttributeMultiprocessorCount, dev);
        if (hipFuncSetAttribute((const void*)fwd_kernel, hipFuncAttributeMaxDynamicSharedMemorySize, LDS_BYTES) != hipSuccess) { fprintf(stderr, "kernel_launch: hipFuncSetAttribute failed\n"); grid = -1; return; }
        if (hipOccupancyMaxActiveBlocksPerMultiprocessor(&per_cu, (const void*)fwd_kernel, 512, LDS_BYTES) != hipSuccess || per_cu < 1) { fprintf(stderr, "kernel_launch: occupancy query says %d\n", per_cu); per_cu = 1; }
        (void)hipGetLastError();
        grid = cus * 1;
        fprintf(stderr, "kernel_launch: cus %d per_cu %d grid %d\n", cus, per_cu, grid);
    }
    if (grid < 0) return;
    if (hipMemsetAsync(d_ws, 0, 65536, stream) != hipSuccess) { fprintf(stderr, "kernel_launch: memset failed\n"); return; }
    Params p{};
    for (int i = 0; i < 25; ++i) p.in[i] = (const float*)d_in[i];
    p.out = (float*)d_out; p.ws = (unsigned char*)d_ws; p.ph_lo = 0; p.ph_hi = 14;
    void* args[] = {&p};
    hipError_t e = hipLaunchCooperativeKernel((const void*)fwd_kernel, dim3(grid), dim3(512), args, LDS_BYTES, stream);
    if (e != hipSuccess) fprintf(stderr, "kernel_launch: cooperative launch failed: %s (grid %d)\n", hipGetErrorString(e), grid);
}
```
